# Optimizing an MI355X kernel written in HIP

```python
import jax, jax.numpy as jnp
from jax import lax
import numpy as np

D_MODEL = 1024
BATCH = 16
SEQ = 4096
DEPTH = 1

HEAD_DIM = 64
DILATED_GROUPS = ((128, 1), (512, 4), (2048, 16))
N_ATT_GROUPS = len(DILATED_GROUPS)
HEADS_PER_GROUP = 4
ATT_HEADS = N_ATT_GROUPS * HEADS_PER_GROUP
ATT_WIDTH = ATT_HEADS * HEAD_DIM
ATT_OUT_WIDTH = HEADS_PER_GROUP * HEAD_DIM
BAND_BLOCK = 128
ROPE_THETA = 10000.0

GMLP_CHUNK = 128
GMLP_GROUPS = 4
GMLP_WIDTH = 512
GMLP_GROUP_WIDTH = GMLP_WIDTH // GMLP_GROUPS

IN_COLS = 3 * ATT_WIDTH + 2 * GMLP_WIDTH + 2 * D_MODEL

N_MEM = 256
XATTN_HEADS = 4
XATTN_HEAD_DIM = D_MODEL // XATTN_HEADS

N_EXPERT_GROUPS = 4
EXPERTS_PER_GROUP = 8
N_EXPERTS = N_EXPERT_GROUPS * EXPERTS_PER_GROUP
TOP_K_INNER = 2
EXPERT_FF = D_MODEL // 2
MOE_BLOCK = 128

RMS_EPS = 1e-6
LN_EPS = 1e-5
NEG_INF = -1e30

kernel_name = "hybrid_dilated_gmlp_hmoe_block"


def rmsnorm(x, g):
    xf = x.astype(jnp.float32)
    y = xf * lax.rsqrt(jnp.mean(xf * xf, axis=-1, keepdims=True) + RMS_EPS)
    return (y * g.astype(jnp.float32)).astype(x.dtype)


def layernorm(x, g, b):
    xf = x.astype(jnp.float32)
    mu = jnp.mean(xf, axis=-1, keepdims=True)
    var = jnp.mean(jnp.square(xf - mu), axis=-1, keepdims=True)
    y = (xf - mu) * lax.rsqrt(var + LN_EPS)
    return (y * g.astype(jnp.float32) + b.astype(jnp.float32)).astype(x.dtype)


def rope(x, positions):
    half = x.shape[-1] // 2
    inv_freq = ROPE_THETA ** (-jnp.arange(half, dtype=jnp.float32) / half)
    ang = positions.astype(jnp.float32)[..., None] * inv_freq
    cos = jnp.cos(ang)[:, :, None, :]
    sin = jnp.sin(ang)[:, :, None, :]
    xf = x.astype(jnp.float32)
    x1, x2 = xf[..., :half], xf[..., half:]
    return jnp.concatenate([x1 * cos - x2 * sin, x2 * cos + x1 * sin], axis=-1).astype(x.dtype)


def dilated_window_attention(q, k, v, window, dilation):
    B, S, H, Dh = q.shape
    span = window // dilation
    L = S // dilation
    nb = -(-L // BAND_BLOCK)
    Lp = nb * BAND_BLOCK

    def to_strided(t):
        t = t.reshape(B, L, dilation, H, Dh).transpose(0, 2, 1, 3, 4)
        t = jnp.pad(t, ((0, 0), (0, 0), (0, Lp - L), (0, 0), (0, 0)))
        return t.reshape(B, dilation, nb, BAND_BLOCK, H, Dh)

    def with_prev(t):
        prev = jnp.pad(t, ((0, 0), (0, 0), (1, 0), (0, 0), (0, 0), (0, 0)))[:, :, :-1]
        return jnp.concatenate([prev, t], axis=3)

    qb = to_strided(q)
    kk = with_prev(to_strided(k))
    vv = with_prev(to_strided(v))

    s = jnp.einsum('brnqhd,brnkhd->brnhqk', qb, kk,
                   preferred_element_type=jnp.float32) * (Dh ** -0.5)
    qi = jnp.arange(BAND_BLOCK)[:, None]
    kc = jnp.arange(2 * BAND_BLOCK)[None, :]
    dist = qi + BAND_BLOCK - kc
    band = (dist >= 0) & (dist <= span)
    blk = jnp.arange(nb)[:, None, None]
    mask = band[None] & ((blk > 0) | (kc[None] >= BAND_BLOCK))
    s = jnp.where(mask[None, None, :, None], s, NEG_INF)

    m = jnp.max(s, axis=-1, keepdims=True)
    p = jnp.exp(s - m)
    den = jnp.sum(p, axis=-1, keepdims=True)
    lse = (m + jnp.log(den))[..., 0]
    o = jnp.einsum('brnhqk,brnkhd->brnqhd', p / den, vv.astype(jnp.float32))

    o = o.reshape(B, dilation, Lp, H, Dh)[:, :, :L].transpose(0, 2, 1, 3, 4).reshape(B, S, H, Dh)
    lse = lse.transpose(0, 1, 2, 4, 3).reshape(B, dilation, Lp, H)[:, :, :L]
    lse = lse.transpose(0, 2, 1, 3).reshape(B, S, H)
    return o, lse


def dilated_mixture(q, k, v):
    outs, lses = [], []
    for g, (window, dilation) in enumerate(DILATED_GROUPS):
        sl = slice(g * HEADS_PER_GROUP, (g + 1) * HEADS_PER_GROUP)
        o, l = dilated_window_attention(q[:, :, sl], k[:, :, sl], v[:, :, sl], window, dilation)
        outs.append(o)
        lses.append(l)
    wts = jax.nn.softmax(jnp.stack(lses, axis=0), axis=0)
    o = jnp.sum(wts[..., None] * jnp.stack(outs, axis=0), axis=0)
    B, S = o.shape[:2]
    return o.reshape(B, S, ATT_OUT_WIDTH)


def chunked_spatial_gating(zb, w_spatial, b_spatial, v_norm_g, v_norm_b):
    B, S, _ = zb.shape
    z = jax.nn.gelu(zb)
    u, v = z[..., :GMLP_WIDTH], z[..., GMLP_WIDTH:]
    v = layernorm(v, v_norm_g, v_norm_b)
    causal = jnp.tril(jnp.ones((GMLP_CHUNK, GMLP_CHUNK), dtype=bool))
    ws = jnp.where(causal[None], w_spatial, 0.0).astype(v.dtype)
    vc = v.reshape(B, S // GMLP_CHUNK, GMLP_CHUNK, GMLP_GROUPS, GMLP_GROUP_WIDTH)
    mixed = jnp.einsum('gts,bnsgc->bntgc', ws, vc) + b_spatial.T[:, :, None].astype(v.dtype)
    return u * mixed.reshape(B, S, GMLP_WIDTH)


def hybrid_mixer(xn, positions, w_in, b_gates, w_spatial, b_spatial, v_norm_g, v_norm_b,
                 w_out_a, w_out_b, w_out):
    B, S, D = xn.shape
    proj = xn @ w_in
    cuts = np.cumsum([ATT_WIDTH, ATT_WIDTH, ATT_WIDTH, 2 * GMLP_WIDTH]).tolist()
    q, k, v, zb, gate_logits = jnp.split(proj, cuts, axis=-1)
    q = rope(q.reshape(B, S, ATT_HEADS, HEAD_DIM), positions)
    k = rope(k.reshape(B, S, ATT_HEADS, HEAD_DIM), positions)
    v = v.reshape(B, S, ATT_HEADS, HEAD_DIM)
    y_a = dilated_mixture(q, k, v).astype(xn.dtype)
    y_b = chunked_spatial_gating(zb, w_spatial, b_spatial, v_norm_g, v_norm_b)
    gates = jax.nn.sigmoid(gate_logits + b_gates)
    g_a, g_b = gates[..., :D], gates[..., D:]
    merged = g_a * (y_a @ w_out_a) + g_b * (y_b @ w_out_b)
    return merged @ w_out


def memory_cross_attention(hn, mn, w_q, w_kv, w_o):
    B, S, D = hn.shape
    M = mn.shape[1]
    q = (hn @ w_q).reshape(B, S, XATTN_HEADS, XATTN_HEAD_DIM)
    kv = (mn @ w_kv).reshape(B, M, 2, XATTN_HEADS, XATTN_HEAD_DIM)
    k, v = kv[:, :, 0], kv[:, :, 1]
    s = jnp.einsum('bshd,bmhd->bhsm', q, k,
                   preferred_element_type=jnp.float32) * (XATTN_HEAD_DIM ** -0.5)
    p = jax.nn.softmax(s, axis=-1)
    o = jnp.einsum('bhsm,bmhd->bshd', p.astype(v.dtype), v).reshape(B, S, D)
    return o @ w_o


def hierarchical_moe(hn, w_router_grp, b_router_grp, w_router_exp, b_router_exp,
                     w_gate_e, w_up_e, w_down_e):
    B, S, D = hn.shape
    T = B * S
    xt = hn.reshape(T, D)
    grp_logits = (xt @ w_router_grp).astype(jnp.float32) + b_router_grp.astype(jnp.float32)
    grp_prob = jax.nn.softmax(grp_logits, axis=-1)
    grp = jnp.argmax(grp_logits, axis=-1).astype(jnp.int32)
    grp_gate = jnp.take_along_axis(grp_prob, grp[:, None], axis=1)[:, 0]
    exp_logits = ((xt @ w_router_exp).astype(jnp.float32) + b_router_exp.astype(jnp.float32))
    exp_logits = exp_logits.reshape(T, N_EXPERT_GROUPS, EXPERTS_PER_GROUP)
    in_grp = jnp.take_along_axis(exp_logits, grp[:, None, None], axis=1)[:, 0]
    top_v, top_i = lax.top_k(in_grp, TOP_K_INNER)
    gate = grp_gate[:, None] * jax.nn.softmax(top_v, axis=-1)

    A = T * TOP_K_INNER
    eid = (grp[:, None] * EXPERTS_PER_GROUP + top_i.astype(jnp.int32)).reshape(A)
    wgt = gate.reshape(A)
    e_sorted, a_sorted = lax.sort((eid, jnp.arange(A, dtype=jnp.int32)), num_keys=1, is_stable=True)
    tok_sorted = a_sorted // TOP_K_INNER
    w_sorted = wgt[a_sorted]

    counts = jax.ops.segment_sum(jnp.ones((A,), jnp.int32), eid, num_segments=N_EXPERTS)
    padded = ((counts + MOE_BLOCK - 1) // MOE_BLOCK) * MOE_BLOCK
    start = jnp.cumsum(counts) - counts
    pend = jnp.cumsum(padded)
    pstart = pend - padded
    dest = pstart[e_sorted] + (jnp.arange(A, dtype=jnp.int32) - start[e_sorted])
    P = A + N_EXPERTS * MOE_BLOCK
    n_blocks = P // MOE_BLOCK
    tok_buf = jnp.full((P,), T, jnp.int32).at[dest].set(tok_sorted)
    w_buf = jnp.zeros((P,), jnp.float32).at[dest].set(w_sorted)
    blk_start = jnp.arange(n_blocks, dtype=jnp.int32) * MOE_BLOCK
    blk_expert = jnp.minimum(jnp.searchsorted(pend, blk_start, side='right'),
                             N_EXPERTS - 1).astype(jnp.int32)

    def expert_block(args):
        idx, e = args
        xb = jnp.take(xt, idx, axis=0, mode='fill', fill_value=0)
        hb = jax.nn.silu(xb @ w_gate_e[e]) * (xb @ w_up_e[e])
        return hb @ w_down_e[e]

    yb = lax.map(expert_block, (tok_buf.reshape(n_blocks, MOE_BLOCK), blk_expert))
    yb = yb.reshape(P, D) * w_buf[:, None].astype(yb.dtype)
    y = jnp.zeros((T, D), yb.dtype).at[tok_buf].add(yb, mode='drop')
    return y.reshape(B, S, D)


def setup_inputs(seed: int = 0) -> dict:
    key = jax.random.key(seed)
    ks = iter(jax.random.split(key, 40))
    f32 = jnp.float32
    L, D = DEPTH, D_MODEL

    def nrm(shape, scale):
        return jax.random.normal(next(ks), shape, f32) * scale

    def gain(shape):
        return 1.0 + nrm(shape, 0.02)

    x = nrm((BATCH, SEQ, D), 1.0)
    mem = nrm((BATCH, N_MEM, D), 1.0)
    positions = (jnp.arange(SEQ, dtype=jnp.int32)[None, :]
                 + jax.random.randint(next(ks), (BATCH, 1), 0, 512, dtype=jnp.int32))
    return {
        "x": x,
        "mem": mem,
        "positions": positions,
        "mix_norm_g": gain((L, D)),
        "w_in": nrm((L, D, IN_COLS), D ** -0.5),
        "b_gates": nrm((L, 2 * D), 0.1),
        "w_spatial": nrm((L, GMLP_GROUPS, GMLP_CHUNK, GMLP_CHUNK), GMLP_CHUNK ** -0.5),
        "b_spatial": 1.0 + nrm((L, GMLP_GROUPS, GMLP_CHUNK), 0.02),
        "v_norm_g": gain((L, GMLP_WIDTH)),
        "v_norm_b": nrm((L, GMLP_WIDTH), 0.02),
        "w_out_a": nrm((L, ATT_OUT_WIDTH, D), ATT_OUT_WIDTH ** -0.5),
        "w_out_b": nrm((L, GMLP_WIDTH, D), GMLP_WIDTH ** -0.5),
        "w_out": nrm((L, D, D), D ** -0.5),
        "xattn_norm_g": gain((L, D)),
        "mem_norm_g": gain((L, D)),
        "w_q_x": nrm((L, D, D), D ** -0.5),
        "w_kv_x": nrm((L, D, 2 * D), D ** -0.5),
        "w_o_x": nrm((L, D, D), D ** -0.5),
        "moe_norm_g": gain((L, D)),
        "w_router_grp": nrm((L, D, N_EXPERT_GROUPS), D ** -0.5),
        "b_router_grp": nrm((L, N_EXPERT_GROUPS), 0.01),
        "w_router_exp": nrm((L, D, N_EXPERTS), D ** -0.5),
        "b_router_exp": nrm((L, N_EXPERTS), 0.01),
        "w_gate_e": nrm((L, N_EXPERTS, D, EXPERT_FF), D ** -0.5),
        "w_up_e": nrm((L, N_EXPERTS, D, EXPERT_FF), D ** -0.5),
        "w_down_e": nrm((L, N_EXPERTS, EXPERT_FF, D), EXPERT_FF ** -0.5),
        "final_norm_g": gain((D,)),
    }


def reference(x, mem, positions, mix_norm_g, w_in, b_gates, w_spatial, b_spatial, v_norm_g,
              v_norm_b, w_out_a, w_out_b, w_out, xattn_norm_g, mem_norm_g, w_q_x, w_kv_x,
              w_o_x, moe_norm_g, w_router_grp, b_router_grp, w_router_exp, b_router_exp,
              w_gate_e, w_up_e, w_down_e, final_norm_g):
    h = x
    for layer in range(DEPTH):
        h = h + hybrid_mixer(rmsnorm(h, mix_norm_g[layer]), positions, w_in[layer],
                             b_gates[layer], w_spatial[layer], b_spatial[layer],
                             v_norm_g[layer], v_norm_b[layer], w_out_a[layer],
                             w_out_b[layer], w_out[layer])
        h = h + memory_cross_attention(rmsnorm(h, xattn_norm_g[layer]),
                                       rmsnorm(mem, mem_norm_g[layer]),
                                       w_q_x[layer], w_kv_x[layer], w_o_x[layer])
        h = h + hierarchical_moe(rmsnorm(h, moe_norm_g[layer]), w_router_grp[layer],
                                 b_router_grp[layer], w_router_exp[layer], b_router_exp[layer],
                                 w_gate_e[layer], w_up_e[layer], w_down_e[layer])
    return rmsnorm(h, final_norm_g)
```

```cpp
#include <hip/hip_runtime.h>
#include <cstdio>
#include <cstdint>
namespace nv {
constexpr int S = 4096, D = 1024, NCOL = 5376, NMEM = 256;
constexpr int C_Q = 0, C_K = 768, C_V = 1536, C_ZB = 2304, C_G = 3328;

__device__ __forceinline__ float wsum(float v) {
#pragma unroll
    for (int o = 32; o >= 1; o >>= 1) v += __shfl_xor(v, o);
    return v;
}
__global__ void __launch_bounds__(256) rmsnorm_rows(const float* __restrict__ x, const float* __restrict__ g, float* __restrict__ y, int rows) {
    const int w = blockIdx.x * 4 + (threadIdx.x >> 6), lane = threadIdx.x & 63;
    if (w >= rows) return;
    const float* xr = x + (size_t)w * D; float v[16]; float ss = 0.f;
#pragma unroll
    for (int i = 0; i < 16; ++i) { v[i] = xr[lane + 64 * i]; ss += v[i] * v[i]; }
    ss = wsum(ss);
    const float r = rsqrtf(ss * (1.0f / D) + 1e-6f);
#pragma unroll
    for (int i = 0; i < 16; ++i) y[(size_t)w * D + lane + 64 * i] = v[i] * r * g[lane + 64 * i];
}
__global__ void __launch_bounds__(256) gemm(const float* __restrict__ A, int lda, const int* __restrict__ arow, int arow_shift,
                                            const float* __restrict__ B, int ldb, long bstride_z, float* __restrict__ C, int ldc,
                                            int M, int N, int K, const int* __restrict__ zcount, const int* __restrict__ zbase) {
    __shared__ float As[16][65]; __shared__ float Bs[16][64];
    const int z = blockIdx.z; int m_lo = 0, Mz = M;
    if (zcount) { m_lo = zbase[z]; Mz = zcount[z]; }
    const int bm = blockIdx.y * 64, bn = blockIdx.x * 64;
    if (bm >= Mz) return;
    const float* Bz = B + (long)z * bstride_z;
    const int tid = threadIdx.x, tx = tid & 15, ty = tid >> 4;
    float acc[4][4];
#pragma unroll
    for (int i = 0; i < 4; ++i)
#pragma unroll
        for (int j = 0; j < 4; ++j) acc[i][j] = 0.f;
    for (int k0 = 0; k0 < K; k0 += 16) {
#pragma unroll
        for (int i = 0; i < 4; ++i) { const int e = tid + i * 256, r = e >> 4, kk = e & 15, gr = bm + r; float v = 0.f;
            if (gr < Mz) { const int src = arow ? (arow[m_lo + gr] >> arow_shift) : (m_lo + gr); v = A[(size_t)src * lda + k0 + kk]; }
            As[kk][r] = v; }
#pragma unroll
        for (int i = 0; i < 4; ++i) { const int e = tid + i * 256, kk = e >> 6, c = e & 63; Bs[kk][c] = Bz[(size_t)(k0 + kk) * ldb + bn + c]; }
        __syncthreads();
#pragma unroll
        for (int kk = 0; kk < 16; ++kk) { float a[4], b[4];
#pragma unroll
            for (int i = 0; i < 4; ++i) { a[i] = As[kk][ty * 4 + i]; b[i] = Bs[kk][tx * 4 + i]; }
#pragma unroll
            for (int i = 0; i < 4; ++i)
#pragma unroll
                for (int j = 0; j < 4; ++j) acc[i][j] += a[i] * b[j]; }
        __syncthreads();
    }
#pragma unroll
    for (int i = 0; i < 4; ++i) { const int gr = bm + ty * 4 + i;
        if (gr < Mz) {
#pragma unroll
            for (int j = 0; j < 4; ++j) C[(size_t)(m_lo + gr) * ldc + bn + tx * 4 + j] = acc[i][j]; } }
}
__global__ void __launch_bounds__(256) rope(float* __restrict__ proj, const int* __restrict__ pos, int ntok) {
    const int idx = blockIdx.x * 256 + threadIdx.x; if (idx >= ntok * 2 * 12 * 32) return;
    const int i = idx & 31, h = (idx >> 5) % 12, qk = (idx / (32 * 12)) & 1, t = idx / (32 * 12 * 2);
    const float inv = powf(10000.0f, -(float)i / 32.0f), ang = (float)pos[t] * inv;
    const float c = cosf(ang), s = sinf(ang);
    float* p = proj + (size_t)t * NCOL + qk * 768 + h * 64 + i;
    const float x1 = p[0], x2 = p[32];
    p[0] = x1 * c - x2 * s; p[32] = x2 * c + x1 * s;
}
__global__ void __launch_bounds__(256) dil_attn(const float* __restrict__ proj, float* __restrict__ ya, int ntok) {
    const int w = blockIdx.x * 4 + (threadIdx.x >> 6), lane = threadIdx.x & 63;
    if (w >= ntok * 4) return;
    const int t = w >> 2, j = w & 3, tl = t % S, tb = t - tl;
    float M2 = -3.0e38f, W = 0.f, Y = 0.f;
    for (int g = 0; g < 3; ++g) {
        const int dil = (g == 0) ? 1 : (g == 1 ? 4 : 16), head = g * 4 + j;
        const float q = proj[(size_t)t * NCOL + C_Q + head * 64 + lane];
        const int lidx = tl / dil, nk = (lidx < 128 ? lidx : 128) + 1;
        float m = -3.0e38f, l = 0.f, acc = 0.f;
        for (int jj = 0; jj < nk; ++jj) {
            const size_t row = (size_t)(tb + tl - jj * dil) * NCOL;
            const float s = wsum(q * proj[row + C_K + head * 64 + lane]) * 0.125f;
            const float mn = fmaxf(m, s), al = expf(m - mn), p = expf(s - mn);
            l = l * al + p; acc = acc * al + p * proj[row + C_V + head * 64 + lane]; m = mn;
        }
        const float o = acc / l, lse = m + logf(l);
        const float Mn = fmaxf(M2, lse), a2 = expf(M2 - Mn), wg = expf(lse - Mn);
        W = W * a2 + wg; Y = Y * a2 + wg * o; M2 = Mn;
    }
    ya[(size_t)t * 256 + j * 64 + lane] = Y / W;
}
__device__ __forceinline__ float gelu_tanh(float x) { const float u = 0.7978845608028654f * (x + 0.044715f * x * x * x); return 0.5f * x * (1.0f + tanhf(u)); }
__global__ void __launch_bounds__(256) gmlp_pre(const float* __restrict__ proj, const float* __restrict__ vg, const float* __restrict__ vb, float* __restrict__ U, float* __restrict__ VLN, int ntok) {
    const int t = blockIdx.x * 4 + (threadIdx.x >> 6), lane = threadIdx.x & 63; if (t >= ntok) return;
    const float* z = proj + (size_t)t * NCOL + C_ZB; float v[8]; float s = 0.f;
#pragma unroll
    for (int i = 0; i < 8; ++i) { U[(size_t)t * 512 + lane + 64 * i] = gelu_tanh(z[lane + 64 * i]); v[i] = gelu_tanh(z[512 + lane + 64 * i]); s += v[i]; }
    const float mean = wsum(s) * (1.0f / 512.0f); float q = 0.f;
#pragma unroll
    for (int i = 0; i < 8; ++i) { const float d = v[i] - mean; q += d * d; }
    const float rstd = rsqrtf(wsum(q) * (1.0f / 512.0f) + 1e-5f);
#pragma unroll
    for (int i = 0; i < 8; ++i) { const int c = lane + 64 * i; VLN[(size_t)t * 512 + c] = (v[i] - mean) * rstd * vg[c] + vb[c]; }
}
__global__ void __launch_bounds__(256) gmlp_mix(const float* __restrict__ U, const float* __restrict__ VLN, const float* __restrict__ wsp, const float* __restrict__ bsp, float* __restrict__ YB, int ntok) {
    const int idx = blockIdx.x * 256 + threadIdx.x; if (idx >= ntok * 512) return;
    const int c = idx & 511, t = idx >> 9, tt = t & 127, base = t - tt, g = c >> 7;
    const float* wr = wsp + ((size_t)g * 128 + tt) * 128; float acc = 0.f;
    for (int s = 0; s <= tt; ++s) acc += wr[s] * VLN[(size_t)(base + s) * 512 + c];
    YB[idx] = U[idx] * (acc + bsp[g * 128 + tt]);
}
__global__ void __launch_bounds__(256) merge_gates(const float* __restrict__ proj, const float* __restrict__ bg, const float* __restrict__ TA, const float* __restrict__ TB, float* __restrict__ out, int ntok) {
    const int idx = blockIdx.x * 256 + threadIdx.x; if (idx >= ntok * D) return;
    const int c = idx & 1023, t = idx >> 10;
    const float la = proj[(size_t)t * NCOL + C_G + c] + bg[c], lb = proj[(size_t)t * NCOL + C_G + 1024 + c] + bg[1024 + c];
    out[idx] = TA[idx] / (1.0f + expf(-la)) + TB[idx] / (1.0f + expf(-lb));
}
__global__ void __launch_bounds__(256) add2(const float* __restrict__ a, const float* __restrict__ b, float* __restrict__ o, int n) {
    const int idx = blockIdx.x * 256 + threadIdx.x; if (idx < n) o[idx] = a[idx] + b[idx];
}
__global__ void __launch_bounds__(256) xattn(const float* __restrict__ Q, const float* __restrict__ KV, float* __restrict__ O, int ntok) {
    const int w = blockIdx.x * 4 + (threadIdx.x >> 6), lane = threadIdx.x & 63; if (w >= ntok * 4) return;
    const int t = w >> 2, h = w & 3, b = t / S;
    float q[4], acc[4] = {0.f, 0.f, 0.f, 0.f};
#pragma unroll
    for (int i = 0; i < 4; ++i) q[i] = Q[(size_t)t * D + h * 256 + lane + 64 * i];
    float m = -3.0e38f, l = 0.f;
    for (int mm = 0; mm < NMEM; ++mm) {
        const float* kr = KV + ((size_t)b * NMEM + mm) * 2048 + h * 256; const float* vr = kr + 1024;
        float s = 0.f;
#pragma unroll
        for (int i = 0; i < 4; ++i) s += q[i] * kr[lane + 64 * i];
        s = wsum(s) * 0.0625f;
        const float mn = fmaxf(m, s), al = expf(m - mn), p = expf(s - mn);
        l = l * al + p;
#pragma unroll
        for (int i = 0; i < 4; ++i) acc[i] = acc[i] * al + p * vr[lane + 64 * i];
        m = mn;
    }
#pragma unroll
    for (int i = 0; i < 4; ++i) O[(size_t)t * D + h * 256 + lane + 64 * i] = acc[i] / l;
}
__global__ void __launch_bounds__(256) router(const float* __restrict__ hn, const float* __restrict__ wg, const float* __restrict__ bg, const float* __restrict__ we, const float* __restrict__ be,
                                              int* __restrict__ eid, float* __restrict__ wgt, int ntok) {
    const int t = blockIdx.x * 4 + (threadIdx.x >> 6), lane = threadIdx.x & 63; if (t >= ntok) return;
    float x[16];
#pragma unroll
    for (int i = 0; i < 16; ++i) x[i] = hn[(size_t)t * D + lane + 64 * i];
    float lg[4], le[32];
#pragma unroll
    for (int c = 0; c < 4; ++c) { float s = 0.f;
#pragma unroll
        for (int i = 0; i < 16; ++i) s += x[i] * wg[(size_t)(lane + 64 * i) * 4 + c];
        lg[c] = wsum(s) + bg[c]; }
#pragma unroll
    for (int c = 0; c < 32; ++c) { float s = 0.f;
#pragma unroll
        for (int i = 0; i < 16; ++i) s += x[i] * we[(size_t)(lane + 64 * i) * 32 + c];
        le[c] = wsum(s) + be[c]; }
    int grp = 0; float gm = lg[0];
#pragma unroll
    for (int c = 1; c < 4; ++c) if (lg[c] > gm) { gm = lg[c]; grp = c; }
    float den = 0.f;
#pragma unroll
    for (int c = 0; c < 4; ++c) den += expf(lg[c] - gm);
    const float ggate = 1.0f / den;
    float v0 = -3.0e38f, v1 = -3.0e38f; int i0 = 0, i1 = 0;
#pragma unroll
    for (int g = 0; g < 4; ++g)
#pragma unroll
        for (int i = 0; i < 8; ++i) { const float v = le[g * 8 + i];
            if (g == grp) { if (v > v0) { v1 = v0; i1 = i0; v0 = v; i0 = i; } else if (v > v1) { v1 = v; i1 = i; } } }
    const float e1 = expf(v1 - v0), p0 = 1.0f / (1.0f + e1), p1 = e1 / (1.0f + e1);
    if (lane == 0) { eid[2 * t] = grp * 8 + i0; eid[2 * t + 1] = grp * 8 + i1; wgt[2 * t] = ggate * p0; wgt[2 * t + 1] = ggate * p1; }
}
__global__ void __launch_bounds__(256) moe_count(const int* __restrict__ eid, int* __restrict__ cnt, int na) {
    const int a = blockIdx.x * 256 + threadIdx.x; if (a < na) atomicAdd(&cnt[eid[a]], 1);
}
__global__ void moe_prefix(const int* __restrict__ cnt, int* __restrict__ base, int* __restrict__ cursor) {
    if (threadIdx.x == 0) { int s = 0; for (int e = 0; e < 32; ++e) { base[e] = s; cursor[e] = 0; s += cnt[e]; } }
}
__global__ void __launch_bounds__(256) moe_fill(const int* __restrict__ eid, const int* __restrict__ base, int* __restrict__ cursor, int* __restrict__ list, int* __restrict__ posof, int na) {
    const int a = blockIdx.x * 256 + threadIdx.x; if (a >= na) return;
    const int e = eid[a], p = base[e] + atomicAdd(&cursor[e], 1); list[p] = a; posof[a] = p;
}
__global__ void __launch_bounds__(256) silu_mul(const float* G, const float* Uu, float* H, int n) {
    const int idx = blockIdx.x * 256 + threadIdx.x; if (idx < n) { const float g = G[idx]; H[idx] = g / (1.0f + expf(-g)) * Uu[idx]; }
}
__global__ void __launch_bounds__(256) moe_final(const float* __restrict__ h2, const float* __restrict__ Y, const int* __restrict__ posof, const float* __restrict__ wgt, const float* __restrict__ g,
                                                 float* __restrict__ out, float* __restrict__ h3dbg, int ntok) {
    const int t = blockIdx.x * 4 + (threadIdx.x >> 6), lane = threadIdx.x & 63; if (t >= ntok) return;
    const int p0 = posof[2 * t], p1 = posof[2 * t + 1]; const float w0 = wgt[2 * t], w1 = wgt[2 * t + 1];
    float v[16]; float ss = 0.f;
#pragma unroll
    for (int i = 0; i < 16; ++i) { const int c = lane + 64 * i; v[i] = h2[(size_t)t * D + c] + w0 * Y[(size_t)p0 * D + c] + w1 * Y[(size_t)p1 * D + c]; ss += v[i] * v[i]; }
    ss = wsum(ss); const float r = rsqrtf(ss * (1.0f / D) + 1e-6f);
#pragma unroll
    for (int i = 0; i < 16; ++i) { const int c = lane + 64 * i; out[(size_t)t * D + c] = v[i] * r * g[c]; if (h3dbg) h3dbg[(size_t)t * D + c] = v[i]; }
}

struct Bufs {
    float *XN, *PROJ, *YA, *U, *VLN, *YB, *TA, *TB, *MERGED, *TMP, *H1, *HN, *Q, *MN, *KV, *O, *H2, *HN2, *HG, *HU, *YC, *WGT;
    int *EID, *CNT, *BASE, *CUR, *LIST, *POSOF;
};
constexpr size_t MiB = 1u << 20;
static Bufs carve(unsigned char* ws) {
    Bufs b; size_t o = 0; auto take = [&](size_t bytes) { unsigned char* p = ws + o; o += (bytes + 255) & ~(size_t)255; return p; };
    b.XN = (float*)take(16 * MiB); b.PROJ = (float*)take(84 * MiB); b.YA = (float*)take(4 * MiB); b.U = (float*)take(8 * MiB); b.VLN = (float*)take(8 * MiB); b.YB = (float*)take(8 * MiB);
    b.TA = (float*)take(16 * MiB); b.TB = (float*)take(16 * MiB); b.MERGED = (float*)take(16 * MiB); b.TMP = (float*)take(16 * MiB); b.H1 = (float*)take(16 * MiB); b.HN = (float*)take(16 * MiB);
    b.Q = (float*)take(16 * MiB); b.MN = (float*)take(1 * MiB); b.KV = (float*)take(2 * MiB); b.O = (float*)take(16 * MiB); b.H2 = (float*)take(16 * MiB); b.HN2 = (float*)take(16 * MiB);
    b.HG = (float*)take(16 * MiB); b.HU = (float*)take(16 * MiB); b.YC = (float*)take(32 * MiB); b.WGT = (float*)take(64 * 1024);
    b.EID = (int*)take(64 * 1024); b.CNT = (int*)take(256); b.BASE = (int*)take(256); b.CUR = (int*)take(256); b.LIST = (int*)take(64 * 1024); b.POSOF = (int*)take(64 * 1024);
    return b;
}
constexpr size_t WS_BYTES = 360 * MiB;

static void forward_batch(void* const* d_in, int b, const Bufs& B, float* out, float* h3dbg, hipStream_t st) {
    const float* x = (const float*)d_in[0] + (size_t)b * S * D; const float* mem = (const float*)d_in[1] + (size_t)b * NMEM * D; const int* pos = (const int*)d_in[2] + (size_t)b * S;
    const float *mix_g = (const float*)d_in[3], *w_in = (const float*)d_in[4], *b_gates = (const float*)d_in[5], *w_sp = (const float*)d_in[6], *b_sp = (const float*)d_in[7], *vn_g = (const float*)d_in[8], *vn_b = (const float*)d_in[9],
                *w_oa = (const float*)d_in[10], *w_ob = (const float*)d_in[11], *w_out = (const float*)d_in[12], *xg = (const float*)d_in[13], *mg = (const float*)d_in[14], *w_q = (const float*)d_in[15], *w_kv = (const float*)d_in[16],
                *w_o = (const float*)d_in[17], *moe_g = (const float*)d_in[18], *w_rg = (const float*)d_in[19], *b_rg = (const float*)d_in[20], *w_re = (const float*)d_in[21], *b_re = (const float*)d_in[22], *w_ge = (const float*)d_in[23],
                *w_ue = (const float*)d_in[24], *w_de = (const float*)d_in[25], *fin_g = (const float*)d_in[26];
    const int T = S;
    auto G = [&](const float* A, int lda, const float* Bm, int ldb, float* C, int ldc, int M, int N, int K) {
        gemm<<<dim3(N / 64, (M + 63) / 64, 1), 256, 0, st>>>(A, lda, nullptr, 0, Bm, ldb, 0, C, ldc, M, N, K, nullptr, nullptr); };
    rmsnorm_rows<<<T / 4, 256, 0, st>>>(x, mix_g, B.XN, T);
    G(B.XN, D, w_in, NCOL, B.PROJ, NCOL, T, NCOL, D);
    rope<<<(T * 2 * 12 * 32) / 256, 256, 0, st>>>(B.PROJ, pos, T);
    dil_attn<<<T, 256, 0, st>>>(B.PROJ, B.YA, T);
    gmlp_pre<<<T / 4, 256, 0, st>>>(B.PROJ, vn_g, vn_b, B.U, B.VLN, T);
    gmlp_mix<<<T * 512 / 256, 256, 0, st>>>(B.U, B.VLN, w_sp, b_sp, B.YB, T);
    G(B.YA, 256, w_oa, D, B.TA, D, T, D, 256);
    G(B.YB, 512, w_ob, D, B.TB, D, T, D, 512);
    merge_gates<<<T * D / 256, 256, 0, st>>>(B.PROJ, b_gates, B.TA, B.TB, B.MERGED, T);
    G(B.MERGED, D, w_out, D, B.TMP, D, T, D, D);
    add2<<<T * D / 256, 256, 0, st>>>(x, B.TMP, B.H1, T * D);
    rmsnorm_rows<<<T / 4, 256, 0, st>>>(B.H1, xg, B.HN, T);
    rmsnorm_rows<<<NMEM / 4, 256, 0, st>>>(mem, mg, B.MN, NMEM);
    G(B.HN, D, w_q, D, B.Q, D, T, D, D);
    G(B.MN, D, w_kv, 2048, B.KV, 2048, NMEM, 2048, D);
    xattn<<<T, 256, 0, st>>>(B.Q, B.KV, B.O, T);
    G(B.O, D, w_o, D, B.TMP, D, T, D, D);
    add2<<<T * D / 256, 256, 0, st>>>(B.H1, B.TMP, B.H2, T * D);
    rmsnorm_rows<<<T / 4, 256, 0, st>>>(B.H2, moe_g, B.HN2, T);
    router<<<T / 4, 256, 0, st>>>(B.HN2, w_rg, b_rg, w_re, b_re, B.EID, B.WGT, T);
    (void)hipMemsetAsync(B.CNT, 0, 256, st);
    moe_count<<<2 * T / 256, 256, 0, st>>>(B.EID, B.CNT, 2 * T);
    moe_prefix<<<1, 64, 0, st>>>(B.CNT, B.BASE, B.CUR);
    moe_fill<<<2 * T / 256, 256, 0, st>>>(B.EID, B.BASE, B.CUR, B.LIST, B.POSOF, 2 * T);
    gemm<<<dim3(512 / 64, 2 * T / 64, 32), 256, 0, st>>>(B.HN2, D, B.LIST, 1, w_ge, 512, (long)D * 512, B.HG, 512, 0, 512, D, B.CNT, B.BASE);
    gemm<<<dim3(512 / 64, 2 * T / 64, 32), 256, 0, st>>>(B.HN2, D, B.LIST, 1, w_ue, 512, (long)D * 512, B.HU, 512, 0, 512, D, B.CNT, B.BASE);
    silu_mul<<<2 * T * 512 / 256, 256, 0, st>>>(B.HG, B.HU, B.HG, 2 * T * 512);
    gemm<<<dim3(D / 64, 2 * T / 64, 32), 256, 0, st>>>(B.HG, 512, nullptr, 0, w_de, D, (long)512 * D, B.YC, D, 0, D, 512, B.CNT, B.BASE);
    moe_final<<<T / 4, 256, 0, st>>>(B.H2, B.YC, B.POSOF, B.WGT, fin_g, out, h3dbg, T);
}
}
extern "C" void kernel_launch(void* const* d_in, const int* in_sizes, int n_in, void* d_out, int out_size, void* d_ws, size_t ws_size, hipStream_t stream) {
    (void)in_sizes; (void)n_in; (void)out_size; (void)ws_size;
    const nv::Bufs B = nv::carve((unsigned char*)d_ws);
    for (int b = 0; b < 16; ++b) nv::forward_batch(d_in, b, B, (float*)d_out + (size_t)b * nv::S * nv::D, nullptr, stream);
}
```

```cpp
#define BUILD_MODE 1
#include <hip/hip_runtime.h>
#include <cstdio>
#include <cstdint>
namespace mk {
#define LAS __attribute__((address_space(3)))
#define GAS __attribute__((address_space(1)))
typedef unsigned short bf16_t;
typedef short bf16x8 __attribute__((ext_vector_type(8)));
typedef short s16x4 __attribute__((ext_vector_type(4)));
typedef float f32x4 __attribute__((ext_vector_type(4)));
typedef float f32x2 __attribute__((ext_vector_type(2)));
typedef unsigned u32x4 __attribute__((ext_vector_type(4)));
typedef unsigned u32x2 __attribute__((ext_vector_type(2)));
constexpr int BM = 256, BK = 64, HALF = 128, HTB = HALF * BK * 2, STAGE_BYTES = 8 * HTB, NXCD = 8, WGM = 8;

__host__ __device__ __forceinline__ int lds_byte(int r, int c) { const int st = (r >> 4) * 2 + (c >> 5), rr = r & 15, cc = c & 31, ob = rr * 64 + cc * 2; return st * 1024 + (ob ^ (((ob >> 9) & 1) << 5)); }
__host__ __device__ __forceinline__ void stage_rc(int b, int& R, int& C) { const int st = b / 1024, sb = b % 1024, swz = sb ^ (((sb >> 9) & 1) << 5); R = (st >> 1) * 16 + swz / 64; C = (st & 1) * 32 + (swz % 64) / 2; }
__host__ __device__ __forceinline__ int perm32(int rho) { const int n = rho >> 4, i = rho & 15; return 8 * (i >> 2) + 4 * n + (i & 3); }

typedef __bf16 bf16x2_t __attribute__((ext_vector_type(2)));
__device__ __forceinline__ unsigned cvt_pk_bf16(float lo, float hi) { const f32x2 v = {lo, hi}; const bf16x2_t b = __builtin_convertvector(v, bf16x2_t); return __builtin_bit_cast(unsigned, b); }
__device__ __forceinline__ float bf_lo(unsigned w) { return __uint_as_float(w << 16); }
__device__ __forceinline__ float bf_hi(unsigned w) { return __uint_as_float(w & 0xffff0000u); }
__device__ __forceinline__ float fast_exp2(float x) { return __builtin_amdgcn_exp2f(x); }
__device__ __forceinline__ float fast_rcp(float x) { return __builtin_amdgcn_rcpf(x); }

struct Unit { const char* A; const char* B; char* C; const int* rows; int pm, pn, z, pad; };

__device__ __forceinline__ void tile_of(int wgid, int nM, int nN, int& pm, int& pn) {
    const int nwg = nM * nN; { const int q = nwg / NXCD, r = nwg % NXCD, xcd = wgid % NXCD, off = wgid / NXCD; wgid = (xcd < r ? xcd * (q + 1) : r * (q + 1) + (xcd - r) * q) + off; }
    const int nig = WGM * nN, gid = wgid / nig, fm = gid * WGM, gsz = (nM - fm) < WGM ? (nM - fm) : WGM;
    pm = fm + ((wgid % nig) % gsz); pn = (wgid % nig) / gsz;
}

template <class Epi, class Sched, bool GATHER = false>
__device__ __forceinline__ void gemm_phase(LAS unsigned char* lds, const int K, const int lda, const int ldb, const Sched& S, const Epi& E) {
    const int tid = threadIdx.x, wid = __builtin_amdgcn_readfirstlane(tid >> 6), lane = tid & 63, wr = wid >> 2, wc = wid & 3, fr = lane & 15, fq = lane >> 4;
    const int nt = K / BK;
    int RA[2], CA[2]; unsigned voffB[2][2];
#pragma unroll
    for (int i = 0; i < 2; ++i) { int R, C; stage_rc(tid * 16 + i * 8192, R, C); const int Rb = Epi::PERM ? ((R & ~31) + perm32(R & 31)) : R; RA[i] = R; CA[i] = C;
        voffB[0][i] = (unsigned)(Rb * ldb + C) * 2u; voffB[1][i] = (unsigned)((Rb + HALF) * ldb + C) * 2u; }
    const size_t kstep = (size_t)(BK * 2);
    const unsigned ldsw = (unsigned)wid * 1024u;
    const int aoff = lds_byte(wr * 64 + fr, fq * 8), boff = lds_byte(wc * 32 + fr, fq * 8);
#define MK_SA(b, h) (((b) * 2 + (h)) * HTB)
#define MK_SB(b, h) ((4 + (b) * 2 + (h)) * HTB)
#define MK_STAGE2(bufoff, gbase, v0, v1) do { \
        __builtin_amdgcn_global_load_lds((const unsigned*)((const char*)(gbase) + (v0)), (LAS unsigned*)(lds + (bufoff) + ldsw), 16, 0, 0); \
        __builtin_amdgcn_global_load_lds((const unsigned*)((const char*)(gbase) + (v1)), (LAS unsigned*)(lds + (bufoff) + ldsw + 8192), 16, 0, 0); } while (0)
#define MK_LDA(dst, b, h) do { _Pragma("unroll") for (int m = 0; m < 4; ++m) _Pragma("unroll") for (int k = 0; k < 2; ++k) dst[m][k] = *(const LAS bf16x8*)(lds + MK_SA(b, h) + aoff + m * 2048 + k * 1024); } while (0)
#define MK_LDB(dst, b, h) do { _Pragma("unroll") for (int n = 0; n < 2; ++n) _Pragma("unroll") for (int k = 0; k < 2; ++k) dst[n][k] = *(const LAS bf16x8*)(lds + MK_SB(b, h) + boff + n * 2048 + k * 1024); } while (0)
#define MK_MMA(ai, bj, At, Bt) do { __builtin_amdgcn_s_setprio(1); _Pragma("unroll") for (int m = 0; m < 4; ++m) _Pragma("unroll") for (int n = 0; n < 2; ++n) _Pragma("unroll") for (int k = 0; k < 2; ++k) \
        acc[ai][bj][m][n] = __builtin_amdgcn_mfma_f32_16x16x32_bf16(Bt[n][k], At[m][k], acc[ai][bj][m][n], 0, 0, 0); __builtin_amdgcn_s_setprio(0); } while (0)
#define MK_WAIT_V(n) asm volatile("s_waitcnt vmcnt(" #n ")" ::: "memory")
#define MK_WAIT_L(n) asm volatile("s_waitcnt lgkmcnt(" #n ")" ::: "memory")
#define MK_BAR __builtin_amdgcn_s_barrier()
#define MK_SCHED __builtin_amdgcn_sched_barrier(0)
    Unit cur, nxt; int ui = 0;
    if (!S.next(0, cur)) return;
    f32x4 acc[2][2][4][2];
#pragma unroll
    for (int a = 0; a < 2; ++a)
#pragma unroll
        for (int b = 0; b < 2; ++b)
#pragma unroll
            for (int m = 0; m < 4; ++m)
#pragma unroll
                for (int n = 0; n < 2; ++n) acc[a][b][m][n] = (f32x4){0.f, 0.f, 0.f, 0.f};
    bf16x8 At[4][2], B0[2][2], B1[2][2];
    unsigned vA[2][2], nvA[2][2];
    auto a_offsets = [&](const Unit& u, unsigned (&v)[2][2]) {
#pragma unroll
        for (int h = 0; h < 2; ++h)
#pragma unroll
            for (int i = 0; i < 2; ++i) { const int r = h * HALF + RA[i]; const int src = GATHER ? ((const GAS int*)u.rows)[r] : r; v[h][i] = (unsigned)(src * lda + CA[i]) * 2u; }
    };
    a_offsets(cur, vA);
    if (GATHER) asm volatile("" : "+v"(vA[0][0]), "+v"(vA[0][1]), "+v"(vA[1][0]), "+v"(vA[1][1]));
    const char* cA = cur.A; const char* cB = cur.B;
    MK_STAGE2(MK_SB(0, 0), cB, voffB[0][0], voffB[0][1]); MK_STAGE2(MK_SB(0, 1), cB, voffB[1][0], voffB[1][1]); MK_STAGE2(MK_SA(0, 0), cA, vA[0][0], vA[0][1]); MK_STAGE2(MK_SA(0, 1), cA, vA[1][0], vA[1][1]);
    if (wr == 1) MK_BAR;
    MK_WAIT_V(2); MK_BAR;
    MK_STAGE2(MK_SB(1, 0), cB + kstep, voffB[0][0], voffB[0][1]); MK_STAGE2(MK_SA(1, 0), cA + kstep, vA[0][0], vA[0][1]); MK_STAGE2(MK_SB(1, 1), cB + kstep, voffB[1][0], voffB[1][1]);
    MK_WAIT_V(6); MK_BAR;
    for (;;) {
        const bool has_next = S.next(ui + 1, nxt);
        const char* nA = has_next ? nxt.A : cA; const char* nB = has_next ? nxt.B : cB;
        if (GATHER) { if (has_next) a_offsets(nxt, nvA); else {
#pragma unroll
            for (int h = 0; h < 2; ++h) { nvA[h][0] = vA[h][0]; nvA[h][1] = vA[h][1]; } }
            asm volatile("" : "+v"(nvA[0][0]), "+v"(nvA[0][1]), "+v"(nvA[1][0]), "+v"(nvA[1][1])); }
#pragma nounroll
        for (int t = 0; t < nt; t += 2) {
            const bool last = (t == nt - 2);
            const char* a1 = cA + (size_t)(t + 1) * kstep;
            const char* a2 = last ? nA : cA + (size_t)(t + 2) * kstep; const char* b2 = last ? nB : cB + (size_t)(t + 2) * kstep;
            const char* a3 = a2 + kstep; const char* b3 = b2 + kstep;
            unsigned w00 = vA[0][0], w01 = vA[0][1], w10 = vA[1][0], w11 = vA[1][1];
            if (GATHER) { if (last) { w00 = nvA[0][0]; w01 = nvA[0][1]; w10 = nvA[1][0]; w11 = nvA[1][1]; } }
            MK_LDB(B0, 0, 0); MK_LDB(B1, 0, 1); MK_SCHED; MK_LDA(At, 0, 0); MK_STAGE2(MK_SA(1, 1), a1, vA[1][0], vA[1][1]);
            MK_WAIT_V(8); MK_WAIT_L(0); MK_BAR; MK_MMA(0, 0, At, B0); MK_MMA(0, 1, At, B1); MK_BAR; MK_SCHED;
            MK_LDA(At, 0, 1); MK_STAGE2(MK_SB(0, 0), b2, voffB[0][0], voffB[0][1]); MK_STAGE2(MK_SB(0, 1), b2, voffB[1][0], voffB[1][1]); MK_STAGE2(MK_SA(0, 0), a2, w00, w01);
            MK_WAIT_V(8); MK_WAIT_L(0); MK_BAR; MK_MMA(1, 0, At, B0); MK_MMA(1, 1, At, B1); MK_BAR; MK_SCHED;
            MK_LDB(B0, 1, 0); MK_LDB(B1, 1, 1); MK_SCHED; MK_LDA(At, 1, 0); MK_STAGE2(MK_SA(0, 1), a2, w10, w11);
            MK_WAIT_V(8); MK_WAIT_L(0); MK_BAR; MK_MMA(0, 0, At, B0); MK_MMA(0, 1, At, B1); MK_BAR; MK_SCHED;
            MK_LDA(At, 1, 1); MK_STAGE2(MK_SB(1, 0), b3, voffB[0][0], voffB[0][1]); MK_STAGE2(MK_SB(1, 1), b3, voffB[1][0], voffB[1][1]); MK_STAGE2(MK_SA(1, 0), a3, w00, w01);
            MK_WAIT_V(8); MK_WAIT_L(0); MK_BAR; MK_MMA(1, 0, At, B0); MK_MMA(1, 1, At, B1); MK_BAR; MK_SCHED;
        }
        if (wr == 0) MK_BAR;
        E(acc, cur, wr, wc, fr, fq);
        if (!has_next) break;
#pragma unroll
        for (int a = 0; a < 2; ++a)
#pragma unroll
            for (int b = 0; b < 2; ++b)
#pragma unroll
                for (int m = 0; m < 4; ++m)
#pragma unroll
                    for (int n = 0; n < 2; ++n) acc[a][b][m][n] = (f32x4){0.f, 0.f, 0.f, 0.f};
        cur = nxt; cA = nA; cB = nB; ++ui;
        if (GATHER) {
#pragma unroll
            for (int h = 0; h < 2; ++h) { vA[h][0] = nvA[h][0]; vA[h][1] = nvA[h][1]; } }
        if (wr == 1) MK_BAR;
    }
    MK_WAIT_V(0);
    MK_BAR;
#undef MK_SA
#undef MK_SB
#undef MK_STAGE2
#undef MK_LDA
#undef MK_LDB
#undef MK_MMA
#undef MK_WAIT_V
#undef MK_WAIT_L
#undef MK_BAR
#undef MK_SCHED
}
constexpr float LOG2E = 1.4426950408889634f;
constexpr float QSCALE = 0.125f * LOG2E;
constexpr float XSCALE = 0.0625f * LOG2E;
#define EPI_ARGS f32x4 (&acc)[2][2][4][2], const Unit& u, int wr, int wc, int fr, int fq
#define FOR_AI_M _Pragma("unroll") for (int ai = 0; ai < 2; ++ai) _Pragma("unroll") for (int m = 0; m < 4; ++m)
#define FOR_BJ _Pragma("unroll") for (int bj = 0; bj < 2; ++bj)
__device__ __forceinline__ u32x4 pack8(const f32x4 a, const f32x4 b) { u32x4 w; w.x = cvt_pk_bf16(a[0], a[1]); w.y = cvt_pk_bf16(a[2], a[3]); w.z = cvt_pk_bf16(b[0], b[1]); w.w = cvt_pk_bf16(b[2], b[3]); return w; }
__device__ __forceinline__ void unpack8(const u32x4 w, f32x4& a, f32x4& b) { a = (f32x4){bf_lo(w.x), bf_hi(w.x), bf_lo(w.y), bf_hi(w.y)}; b = (f32x4){bf_lo(w.z), bf_hi(w.z), bf_lo(w.w), bf_hi(w.w)}; }
__device__ __forceinline__ float sigm(float x) { return fast_rcp(1.0f + fast_exp2(-LOG2E * x)); }
__device__ __forceinline__ float gelu_t(float x) { const float u2 = 1.5957691216057308f * x * (1.0f + 0.044715f * x * x); return x * fast_rcp(1.0f + fast_exp2(-LOG2E * u2)); }
__device__ __forceinline__ float rinv16(const float* ssq, size_t row) {
    const f32x4* p = (const f32x4*)(ssq + row * 16); const f32x4 a = p[0], b = p[1], c = p[2], d = p[3];
    const float s = ((a[0] + a[1]) + (a[2] + a[3])) + ((b[0] + b[1]) + (b[2] + b[3])) + ((c[0] + c[1]) + (c[2] + c[3])) + ((d[0] + d[1]) + (d[2] + d[3]));
    return rsqrtf(s * (1.0f / 1024.0f) + 1e-6f);
}

#define GRP(ld, esz) ((size_t)(ai * HALF + m * 16) * (size_t)(ld) * (esz))
#define FENCE_ODD_M if (m & 1) asm volatile("" ::: "memory")
struct EpiProj {
    static constexpr bool PERM = true;
    unsigned char* sb; size_t un; const float* rope; const float* bgates;
    __device__ __forceinline__ void operator()(EPI_ARGS) const {
        const int pn = u.pn; const int rt0 = wr * 64 + fr, cl = wc * 32 + 8 * fq; const size_t prow = (size_t)u.pm * BM;
        if (pn < 9) {
            const int sel = pn / 3, colt = (pn - 3 * sel) * 256; char* ob = (char*)(sb + (size_t)(96 * sel) * un) + (prow * 768 + colt) * 2; const unsigned vo = (unsigned)(rt0 * 768 + cl) * 2u;
            if (sel < 2) { const float sc = sel == 0 ? QSCALE : 1.0f; const char* tb = (const char*)rope + prow * 256; const unsigned vt = (unsigned)(rt0 * 64 + ((cl & 63) >> 1)) * 4u;
                FOR_AI_M { const char* tr = tb + GRP(64, 4) + vt; char* orow = ob + GRP(768, 2) + vo;
                    const f32x4 cs = *(const f32x4*)(tr) * sc, sn = *(const f32x4*)(tr + 128) * sc;
                    FOR_BJ { const f32x4 v0 = acc[ai][bj][m][0], v1 = acc[ai][bj][m][1];
                        const f32x4 o0 = {v0[0] * cs[0] - v0[1] * sn[0], v0[1] * cs[0] + v0[0] * sn[0], v0[2] * cs[1] - v0[3] * sn[1], v0[3] * cs[1] + v0[2] * sn[1]};
                        const f32x4 o1 = {v1[0] * cs[2] - v1[1] * sn[2], v1[1] * cs[2] + v1[0] * sn[2], v1[2] * cs[3] - v1[3] * sn[3], v1[3] * cs[3] + v1[2] * sn[3]};
                        *(u32x4*)(orow + bj * 256) = pack8(o0, o1); }
                    FENCE_ODD_M; }
            } else {
                FOR_AI_M { char* orow = ob + GRP(768, 2) + vo; FOR_BJ *(u32x4*)(orow + bj * 256) = pack8(acc[ai][bj][m][0], acc[ai][bj][m][1]); }
            }
        } else if (pn < 13) {
            char* ob = (char*)(sb + (size_t)(pn < 11 ? 288 : 352) * un) + (prow * 512 + ((pn - 9) & 1) * 256) * 2; const unsigned vo = (unsigned)(rt0 * 512 + cl) * 2u;
            FOR_AI_M { char* orow = ob + GRP(512, 2) + vo;
                FOR_BJ { f32x4 a = acc[ai][bj][m][0], b = acc[ai][bj][m][1];
#pragma unroll
                    for (int e = 0; e < 4; ++e) { a[e] = gelu_t(a[e]); b[e] = gelu_t(b[e]); }
                    *(u32x4*)(orow + bj * 256) = pack8(a, b); } }
        } else {
            char* ob = (char*)(sb + (size_t)(pn < 17 ? 416 : 544) * un) + (prow * 1024 + ((pn - 13) & 3) * 256) * 2; const unsigned vo = (unsigned)(rt0 * 1024 + cl) * 2u;
            const char* bb = (const char*)(bgates + (pn - 13) * 256); const unsigned vb = (unsigned)cl * 4u;
            f32x4 bv[2][2];
            FOR_BJ { bv[bj][0] = *(const f32x4*)(bb + bj * 512 + vb); bv[bj][1] = *(const f32x4*)(bb + bj * 512 + 16 + vb); }
            FOR_AI_M { char* orow = ob + GRP(1024, 2) + vo;
                FOR_BJ { f32x4 a = acc[ai][bj][m][0] + bv[bj][0], b = acc[ai][bj][m][1] + bv[bj][1];
#pragma unroll
                    for (int e = 0; e < 4; ++e) { a[e] = sigm(a[e]); b[e] = sigm(b[e]); }
                    *(u32x4*)(orow + bj * 256) = pack8(a, b); } }
        }
    }
};
struct EpiPlain {
    static constexpr bool PERM = true;
    int ldc; float scale;
    __device__ __forceinline__ void operator()(EPI_ARGS) const {
        const int rt0 = wr * 64 + fr, cl = wc * 32 + 8 * fq; const unsigned vo = (unsigned)(rt0 * ldc + cl) * 2u;
        FOR_AI_M { char* orow = u.C + GRP(ldc, 2) + vo;
            FOR_BJ *(u32x4*)(orow + bj * 256) = pack8(acc[ai][bj][m][0] * scale, acc[ai][bj][m][1] * scale); }
    }
};
template <bool ADD> struct EpiGate {
    static constexpr bool PERM = true;
    const bf16_t* G; const bf16_t* M1; bf16_t* O;
    __device__ __forceinline__ void operator()(EPI_ARGS) const {
        const int rt0 = wr * 64 + fr, cl = wc * 32 + 8 * fq; const size_t tb = ((size_t)u.pm * BM * 1024 + (size_t)u.pn * BM) * 2; const unsigned vo = (unsigned)(rt0 * 1024 + cl) * 2u;
        FOR_AI_M { const size_t go = tb + GRP(1024, 2);
            FOR_BJ { f32x4 g0, g1; unpack8(*(const u32x4*)((const char*)G + go + bj * 256 + vo), g0, g1); f32x4 a = g0 * acc[ai][bj][m][0], b = g1 * acc[ai][bj][m][1];
                if (ADD) { f32x4 m0, m1; unpack8(*(const u32x4*)((const char*)M1 + go + bj * 256 + vo), m0, m1); a += m0; b += m1; }
                *(u32x4*)((char*)O + go + bj * 256 + vo) = pack8(a, b); }
            FENCE_ODD_M; }
    }
};
template <bool BASE_F32> struct EpiResid {
    static constexpr bool PERM = true;
    const float* bf; const bf16_t* bh; bf16_t* O; float* ssq;
    __device__ __forceinline__ void operator()(EPI_ARGS) const {
        const int rt0 = wr * 64 + fr, cl = wc * 32 + 8 * fq; const size_t te = (size_t)u.pm * BM * 1024 + (size_t)u.pn * BM; const unsigned ve = (unsigned)(rt0 * 1024 + cl);
        char* sq = (char*)ssq + ((size_t)u.pm * BM * 16 + u.pn * 4 + wc) * 4; const unsigned vs = (unsigned)rt0 * 64u;
        FOR_AI_M { const size_t ge = te + GRP(1024, 1); float s = 0.f;
            FOR_BJ { f32x4 a, b;
                if (BASE_F32) { const char* p = (const char*)bf + (ge + bj * HALF) * 4 + ve * 4u; a = *(const f32x4*)p; b = *(const f32x4*)(p + 16); } else unpack8(*(const u32x4*)((const char*)bh + (ge + bj * HALF) * 2 + ve * 2u), a, b);
                a += acc[ai][bj][m][0]; b += acc[ai][bj][m][1];
                s += (a[0] * a[0] + a[1] * a[1]) + (a[2] * a[2] + a[3] * a[3]) + (b[0] * b[0] + b[1] * b[1]) + (b[2] * b[2] + b[3] * b[3]);
                *(u32x4*)((char*)O + (ge + bj * HALF) * 2 + ve * 2u) = pack8(a, b); }
            s += __shfl_xor(s, 16); s += __shfl_xor(s, 32);
            if (fq == 0) *(float*)(sq + GRP(16, 4) + vs) = s;
            FENCE_ODD_M; }
    }
};
struct EpiScores {
    static constexpr bool PERM = true;
    const float* ssq; bf16_t* O; LAS float* xch; int tid;
    __device__ __forceinline__ void operator()(EPI_ARGS) const {
        const int rt0 = wr * 64 + fr, cl = wc * 32 + 8 * fq; LAS float* xl = xch + rt0 * 4;
        if (tid < 256) xch[2048 + tid] = rinv16(ssq, (size_t)u.pm * BM + tid);
        asm volatile("s_waitcnt lgkmcnt(0)" ::: "memory"); __builtin_amdgcn_s_barrier(); asm volatile("" ::: "memory");
        FOR_AI_M { const int ro = ai * HALF + m * 16; const float r = xch[2048 + rt0 + ro]; float mx = -3.0e38f;
            FOR_BJ {
#pragma unroll
                for (int n = 0; n < 2; ++n) { acc[ai][bj][m][n] *= r; const f32x4 v = acc[ai][bj][m][n]; mx = fmaxf(fmaxf(mx, fmaxf(v[0], v[1])), fmaxf(v[2], v[3])); } }
            mx = fmaxf(mx, __shfl_xor(mx, 16)); mx = fmaxf(mx, __shfl_xor(mx, 32));
            if (fq == 0) xl[ro * 4 + wc] = mx; }
        asm volatile("s_waitcnt lgkmcnt(0)" ::: "memory"); __builtin_amdgcn_s_barrier(); asm volatile("" ::: "memory");
        FOR_AI_M { const int ro = ai * HALF + m * 16; const f32x4 q = *(const LAS f32x4*)(xl + ro * 4); const float M = fmaxf(fmaxf(q[0], q[1]), fmaxf(q[2], q[3])); float s = 0.f;
            FOR_BJ {
#pragma unroll
                for (int n = 0; n < 2; ++n) { f32x4 v = acc[ai][bj][m][n];
#pragma unroll
                    for (int e = 0; e < 4; ++e) { v[e] = fast_exp2(v[e] - M); s += v[e]; }
                    acc[ai][bj][m][n] = v; } }
            s += __shfl_xor(s, 16); s += __shfl_xor(s, 32);
            if (fq == 0) xl[1024 + ro * 4 + wc] = s; }
        asm volatile("s_waitcnt lgkmcnt(0)" ::: "memory"); __builtin_amdgcn_s_barrier(); asm volatile("" ::: "memory");
        char* ob = (char*)O + ((size_t)u.pm * BM * 1024 + (size_t)u.pn * BM) * 2; const unsigned vo = (unsigned)(rt0 * 1024 + cl) * 2u;
        FOR_AI_M { const int ro = ai * HALF + m * 16; const f32x4 q = *(const LAS f32x4*)(xl + 1024 + ro * 4); const float inv = fast_rcp((q[0] + q[1]) + (q[2] + q[3]));
            char* orow = ob + GRP(1024, 2) + vo;
            FOR_BJ *(u32x4*)(orow + bj * 256) = pack8(acc[ai][bj][m][0] * inv, acc[ai][bj][m][1] * inv); }
    }
};
struct EpiMoe1 {
    static constexpr bool PERM = true;
    const float* ssq; LAS float* xch; int tid;
    __device__ __forceinline__ void operator()(EPI_ARGS) const {
        const int rt0 = wr * 64 + fr, cl = wc * 32 + 8 * fq; const unsigned vo = (unsigned)(rt0 * 512 + cl) * 2u;
        if (tid < 256) xch[2048 + tid] = rinv16(ssq, (size_t)((const GAS int*)u.rows)[tid]);
        asm volatile("s_waitcnt lgkmcnt(0)" ::: "memory"); __builtin_amdgcn_s_barrier(); asm volatile("" ::: "memory");
        FOR_AI_M { const float r = xch[2048 + rt0 + ai * HALF + m * 16];
            f32x4 g0 = acc[ai][0][m][0] * r, g1 = acc[ai][0][m][1] * r; const f32x4 u0 = acc[ai][1][m][0] * r, u1 = acc[ai][1][m][1] * r;
#pragma unroll
            for (int e = 0; e < 4; ++e) { g0[e] = g0[e] * sigm(g0[e]) * u0[e]; g1[e] = g1[e] * sigm(g1[e]) * u1[e]; }
            *(u32x4*)(u.C + GRP(512, 2) + vo) = pack8(g0, g1); }
    }
};
struct EpiMoe2 {
    static constexpr bool PERM = true;
    const float* wbuf;
    __device__ __forceinline__ void operator()(EPI_ARGS) const {
        const int rt0 = wr * 64 + fr, cl = wc * 32 + 8 * fq; const unsigned vo = (unsigned)(rt0 * 1024 + cl) * 2u; const char* wb = (const char*)(wbuf + (size_t)u.pm * BM); const unsigned vw = (unsigned)rt0 * 4u;
        FOR_AI_M { const float w = *(const float*)(wb + GRP(1, 4) + vw); char* orow = u.C + GRP(1024, 2) + vo;
            FOR_BJ *(u32x4*)(orow + bj * 256) = pack8(acc[ai][bj][m][0] * w, acc[ai][bj][m][1] * w); }
    }
};

struct SchedFlat {
    const char* A; const char* B; char* C; size_t a_tile, b_tile, b_z, c_row, c_col; int nM, nN, pm_per_z, G, c;
    __device__ __forceinline__ bool next(int i, Unit& u) const {
        const long L = (long)i * G + c; if (L >= (long)nM * nN) return false;
        int pm, pn; tile_of((int)L, nM, nN, pm, pn); u.pm = pm; u.pn = pn; u.z = pm / pm_per_z; u.pad = 0;
        u.A = A + (size_t)pm * a_tile; u.B = B + (size_t)u.z * b_z + (size_t)pn * b_tile; u.C = C + (size_t)pm * c_row + (size_t)pn * c_col; u.rows = nullptr; return true; }
};
struct SchedWqk {
    const char* KVX; const char* WQS; char* WQK; int nz, G, c;
    __device__ __forceinline__ bool next(int i, Unit& u) const {
        const int L = i * G + c; if (L >= nz * 4) return false;
        const int z = L >> 2, pn = L & 3, b = z >> 2, h = z & 3; u.pm = 0; u.pn = pn; u.z = z; u.pad = 0; u.rows = nullptr;
        u.A = KVX + ((size_t)b * 256 * 2048 + h * 256) * 2; u.B = WQS + ((size_t)pn * 256 * 1024 + h * 256) * 2; u.C = WQK + ((size_t)b * 1048576 + (size_t)h * 256 * 1024 + pn * 256) * 2; return true; }
};
struct SchedVwo {
    const char* WOT; const char* KVX; char* VWO; int nz, G, c;
    __device__ __forceinline__ bool next(int i, Unit& u) const {
        const int L = i * G + c; if (L >= nz * 4) return false;
        const int z = L >> 2, pm = L & 3, b = z >> 2, h = z & 3; u.pm = pm; u.pn = 0; u.z = z; u.pad = 0; u.rows = nullptr;
        u.A = WOT + ((size_t)pm * 256 * 1024 + h * 256) * 2; u.B = KVX + ((size_t)b * 256 * 2048 + 1024 + h * 256) * 2; u.C = VWO + ((size_t)b * 1048576 + (size_t)pm * 256 * 1024 + h * 256) * 2; return true; }
};
struct SchedMoe {
    const char* A; const char* Bw; char* C; const int* rowtok; const int* tile_e; const int* ntiles; size_t a_row  , b_e, b_tile, c_row, c_col; int G, cv;
    __device__ __forceinline__ bool next(int i, Unit& u) const {
        const int L = i * G + cv, rt = L >> 2, pn = L & 3;
        const int nt = __builtin_amdgcn_readfirstlane(__hip_atomic_load(ntiles, __ATOMIC_RELAXED, __HIP_MEMORY_SCOPE_AGENT)); if (rt >= nt) return false;
        const int e = __builtin_amdgcn_readfirstlane(__hip_atomic_load(tile_e + rt, __ATOMIC_RELAXED, __HIP_MEMORY_SCOPE_AGENT));
        u.pm = rt; u.pn = pn; u.z = e; u.pad = 0; u.rows = rowtok + (size_t)rt * 256;
        u.A = A + (size_t)rt * 256 * a_row; u.B = Bw + (size_t)e * b_e + (size_t)pn * b_tile; u.C = C + (size_t)rt * 256 * c_row + (size_t)pn * c_col; return true; }
};
struct Params {
    const float* in[27]; float* out; unsigned* ctl;
    bf16_t *WIN_T, *WKV_T, *WA_T, *WB_T, *WOUT_T, *WQS, *WO_T, *WR_T, *WGU_T, *WD_T, *WSP;
    bf16_t *XN, *MN, *KVX, *Q, *K, *V, *ZU, *ZV, *GA, *GB, *OG, *YA, *YB, *M1, *MERGED, *H1, *PX, *H2, *WQK, *VWO, *HB, *YBX;
    float *ROPE, *LSE, *SSQ1, *SSQ2, *WGT, *WBUF;
    int *EID, *BCNT, *TOT, *ROWTOK, *POSOF, *TILE_E;
    int nb, T, b0, ph_lo, ph_hi, pad;
};
struct Ctx { LAS unsigned char* lds; int tid, lane, wave, vcu, G, gw, ngw; };
#define LDS_WAIT() asm volatile("s_waitcnt lgkmcnt(0)" ::: "memory")
#define VM_WAIT() asm volatile("s_waitcnt vmcnt(0)" ::: "memory")
__device__ __forceinline__ float wave_sum(float v) {
#pragma unroll
    for (int o = 1; o < 64; o <<= 1) v += __shfl_xor(v, o);
    return v;
}
typedef short v4i16_t __attribute__((ext_vector_type(4)));
__device__ __forceinline__ s16x4 tr_read(LAS unsigned char* p) { return __builtin_bit_cast(s16x4, __builtin_amdgcn_ds_read_tr16_b64_v4i16((LAS v4i16_t*)p)); }

__device__ __forceinline__ int rowmap(int mode, int n) {
    if (mode == 1) { if (n < 1536) { const int d = n & 63; return (n & ~63) + 2 * (d & 31) + (d >> 5); } return n; }
    if (mode == 2) return (n >> 7) * 256 + (n & 127);
    if (mode == 3) return (n >> 7) * 256 + 128 + (n & 127);
    return n;
}
__device__ __forceinline__ void tr_item(const float* W, int ldw, int K, bf16_t* WT, const float* kscale, int mode, LAS float* scr, int kb, int nbk, int lane) {
    const int k0 = 64 * kb, n0 = 32 * nbk;
#pragma unroll 8
    for (int i = 0; i < 32; ++i) { const int kk = 2 * i + (lane >> 5); float v = W[(size_t)(k0 + kk) * ldw + n0 + (lane & 31)]; if (kscale) v *= kscale[k0 + kk]; scr[kk * 33 + (lane & 31)] = v; }
    LDS_WAIT(); asm volatile("" ::: "memory");
    const int c = lane & 7;
#pragma unroll
    for (int j = 0; j < 4; ++j) { const int n = (lane >> 3) + 8 * j; const LAS float* s = scr + (8 * c) * 33 + n;
        u32x4 o; o.x = cvt_pk_bf16(s[0 * 33], s[1 * 33]); o.y = cvt_pk_bf16(s[2 * 33], s[3 * 33]); o.z = cvt_pk_bf16(s[4 * 33], s[5 * 33]); o.w = cvt_pk_bf16(s[6 * 33], s[7 * 33]);
        *(u32x4*)(WT + (size_t)rowmap(mode, n0 + n) * K + k0 + 8 * c) = o; }
    LDS_WAIT(); asm volatile("" ::: "memory");
}
__device__ __forceinline__ void rms_row_bf16(const float* xrow, const float* g, bf16_t* orow, int lane) {
    const f32x4* xr = (const f32x4*)xrow + lane; const f32x4* gr = (const f32x4*)g + lane;
    f32x4 v[4]; float s = 0.f;
#pragma unroll
    for (int j = 0; j < 4; ++j) { v[j] = xr[64 * j]; s += (v[j][0] * v[j][0] + v[j][1] * v[j][1]) + (v[j][2] * v[j][2] + v[j][3] * v[j][3]); }
    const float r = rsqrtf(wave_sum(s) * (1.0f / 1024.0f) + 1e-6f);
    u32x2* o8 = (u32x2*)orow + lane;
#pragma unroll
    for (int j = 0; j < 4; ++j) { const f32x4 gg = gr[64 * j]; u32x2 w; w.x = cvt_pk_bf16(v[j][0] * r * gg[0], v[j][1] * r * gg[1]); w.y = cvt_pk_bf16(v[j][2] * r * gg[2], v[j][3] * r * gg[3]); o8[64 * j] = w; }
}
__device__ __forceinline__ void p0_prologue(const Params& P, const Ctx& X) {
    LAS float* scr = (LAS float*)(X.lds + X.wave * 16384);
    const float *w_in = P.in[4], *w_oa = P.in[10], *w_ob = P.in[11], *w_out = P.in[12], *xg = P.in[13], *w_q = P.in[15], *w_kv = P.in[16], *w_o = P.in[17], *moe_g = P.in[18],
                *w_rg = P.in[19], *w_re = P.in[21], *w_ge = P.in[23], *w_ue = P.in[24], *w_de = P.in[25], *w_sp = P.in[6];
    constexpr int I_IN = 16 * 168, I_KV = 16 * 64, I_A = 4 * 32, I_B = 8 * 32, I_OUT = 16 * 32, I_O = 16 * 32, I_G = 16 * 16 * 32, I_U = I_G, I_D = 8 * 32 * 32;
    constexpr int NITEMS = I_IN + I_KV + I_A + I_B + I_OUT + I_O + I_G + I_U + I_D;
    for (int it = X.gw; it < NITEMS; it += X.ngw) {
        int r = it;
        if (r < I_IN) { tr_item(w_in, 5376, 1024, P.WIN_T, nullptr, 1, scr, r / 168, r % 168, X.lane); continue; } r -= I_IN;
        if (r < I_KV) { tr_item(w_kv, 2048, 1024, P.WKV_T, nullptr, 0, scr, r / 64, r % 64, X.lane); continue; } r -= I_KV;
        if (r < I_A) { tr_item(w_oa, 1024, 256, P.WA_T, nullptr, 0, scr, r / 32, r % 32, X.lane); continue; } r -= I_A;
        if (r < I_B) { tr_item(w_ob, 1024, 512, P.WB_T, nullptr, 0, scr, r / 32, r % 32, X.lane); continue; } r -= I_B;
        if (r < I_OUT) { tr_item(w_out, 1024, 1024, P.WOUT_T, nullptr, 0, scr, r / 32, r % 32, X.lane); continue; } r -= I_OUT;
        if (r < I_O) { tr_item(w_o, 1024, 1024, P.WO_T, nullptr, 0, scr, r / 32, r % 32, X.lane); continue; } r -= I_O;
        if (r < I_G) { const int e = r >> 8, q = r & 255; tr_item(w_ge + (size_t)e * 524288, 512, 1024, P.WGU_T + (size_t)e * 1048576, moe_g, 2, scr, q >> 4, q & 15, X.lane); continue; } r -= I_G;
        if (r < I_U) { const int e = r >> 8, q = r & 255; tr_item(w_ue + (size_t)e * 524288, 512, 1024, P.WGU_T + (size_t)e * 1048576, moe_g, 3, scr, q >> 4, q & 15, X.lane); continue; } r -= I_U;
        { const int e = r >> 8, q = r & 255; tr_item(w_de + (size_t)e * 524288, 1024, 512, P.WD_T + (size_t)e * 524288, nullptr, 0, scr, q >> 5, q & 31, X.lane); }
    }
    const int gt = X.gw * 64 + X.lane, ngt = X.ngw * 64;
    for (int i = gt; i < 1024 * 128; i += ngt) { const int row = i >> 7; const float g = xg[row]; const f32x4 a = *(const f32x4*)(w_q + (size_t)i * 8) * g, b = *(const f32x4*)(w_q + (size_t)i * 8 + 4) * g; *(u32x4*)(P.WQS + (size_t)i * 8) = pack8(a, b); }
    for (int i = gt; i < 48 * 1024; i += ngt) { const int row = i >> 10, k = i & 1023; float v = 0.f; if (row < 4) v = w_rg[k * 4 + row]; else if (row < 36) v = w_re[k * 32 + row - 4];
        P.WR_T[i] = (bf16_t)(cvt_pk_bf16(v * moe_g[k], 0.f) & 0xffffu); }
    for (int i = gt; i < 4 * 128 * 128; i += ngt) { const int s = i & 127, t = (i >> 7) & 127; P.WSP[i] = (bf16_t)(cvt_pk_bf16(s <= t ? w_sp[i] : 0.f, 0.f) & 0xffffu); }
    { const int* pos = (const int*)P.in[2] + (size_t)P.b0 * 4096;
      for (int i = gt; i < P.T * 32; i += ngt) { const int t = i >> 5, f = i & 31; const float ang = (float)pos[t] * powf(10000.0f, -(float)f / 32.0f); P.ROPE[(size_t)t * 64 + f] = cosf(ang); P.ROPE[(size_t)t * 64 + 32 + f] = sinf(ang); } }
    { const float* x = P.in[0] + (size_t)P.b0 * 4096 * 1024; const float* mem = P.in[1] + (size_t)P.b0 * 256 * 1024;
      for (int m = X.gw; m < P.T; m += X.ngw) rms_row_bf16(x + (size_t)m * 1024, P.in[3], P.XN + (size_t)m * 1024, X.lane);
      for (int m = X.gw; m < P.nb * 256; m += X.ngw) rms_row_bf16(mem + (size_t)m * 1024, P.in[14], P.MN + (size_t)m * 1024, X.lane); }
}

__device__ __forceinline__ void attn_phase(const Params& P, const Ctx& X) {
    LAS unsigned char* Ks = X.lds; LAS unsigned char* Vs = X.lds + 32768;
    const int lane = X.lane, w = X.wave, fr = lane & 15, fq = lane >> 4;
    const int nunits = P.nb * 384;
    const int srow = X.tid >> 3, sch = X.tid & 7;
    const unsigned ldsk = (unsigned)(srow * 128 + ((sch ^ ((srow >> 1) & 7)) << 4)), ldsv = (unsigned)(srow * 128 + ((sch ^ (srow & 7)) << 4));
    for (int U = X.vcu; U < nunits; U += X.G) {
        const int b = U / 384, rem = U - b * 384, head = rem >> 5, blk = rem & 31, g = head >> 2, j = head & 3;
        const int dsh = 2 * g, dil = 1 << dsh, nbk = 32 >> dsh, r = blk / nbk, n = blk - r * nbk;
        const long ebase = ((long)b * 4096 + (long)(n - 1) * 128 * dil + r) * 768 + head * 64;
        const unsigned vsrc = (unsigned)(srow * dil * 768 + sch * 8) * 2u; const size_t pstride = (size_t)64 * dil * 768 * 2;
        const char* kb = (const char*)P.K + ebase * 2; const char* vb = (const char*)P.V + ebase * 2;
        u32x4 kreg[4], vreg[4];
#pragma unroll
        for (int p = 0; p < 4; ++p) {
            if (p >= 2 || n > 0) { kreg[p] = *(const u32x4*)(kb + p * pstride + vsrc); vreg[p] = *(const u32x4*)(vb + p * pstride + vsrc); }
            else { kreg[p] = (u32x4){0u, 0u, 0u, 0u}; vreg[p] = (u32x4){0u, 0u, 0u, 0u}; } }
        const unsigned vq = (unsigned)((128 + 16 * w + fr) * dil * 768 + 8 * fq) * 2u;
        const bf16x8 q0 = *(const bf16x8*)((const char*)P.Q + ebase * 2 + vq), q1 = *(const bf16x8*)((const char*)P.Q + ebase * 2 + 64 + vq);
        __syncthreads();
#pragma unroll
        for (int p = 0; p < 4; ++p) { *(LAS u32x4*)(Ks + p * 8192 + ldsk) = kreg[p]; *(LAS u32x4*)(Vs + p * 8192 + ldsv) = vreg[p]; }
        __syncthreads();
        const int s0 = w < 6 ? w : 6;
        f32x4 sc[10];
        { const int row0 = 16 * s0 + fr; const int sw = (row0 >> 1) & 7;
          LAS unsigned char* kp0 = Ks + row0 * 128 + ((fq ^ sw) << 4); LAS unsigned char* kp1 = Ks + row0 * 128 + (((4 + fq) ^ sw) << 4);
#pragma unroll
          for (int st = 0; st < 10; ++st) { const bf16x8 k0 = *(const LAS bf16x8*)(kp0 + st * 2048), k1 = *(const LAS bf16x8*)(kp1 + st * 2048);
            f32x4 a = {0.f, 0.f, 0.f, 0.f}; a = __builtin_amdgcn_mfma_f32_16x16x32_bf16(k0, q0, a, 0, 0, 0); a = __builtin_amdgcn_mfma_f32_16x16x32_bf16(k1, q1, a, 0, 0, 0); sc[st] = a; } }
        const int qi = 16 * w + fr, kc0 = 16 * s0 + 4 * fq - qi, klo = n > 0 ? 0 : 128 - qi; float mx = -3.0e38f;
#pragma unroll
        for (int st = 0; st < 10; ++st)
#pragma unroll
            for (int e = 0; e < 4; ++e) { const int dk = kc0 + 16 * st + e; const bool ok = (dk >= 0) && (dk <= 128) && (dk >= klo); sc[st][e] = ok ? sc[st][e] : -3.0e38f; mx = fmaxf(mx, sc[st][e]); }
        mx = fmaxf(mx, __shfl_xor(mx, 16)); mx = fmaxf(mx, __shfl_xor(mx, 32));
        float l = 0.f;
#pragma unroll
        for (int st = 0; st < 10; ++st)
#pragma unroll
            for (int e = 0; e < 4; ++e) { const float pe = sc[st][e] > -1.0e38f ? fast_exp2(sc[st][e] - mx) : 0.f; sc[st][e] = pe; l += pe; }
        l += __shfl_xor(l, 16); l += __shfl_xor(l, 32);
        f32x4 o[4];
#pragma unroll
        for (int dt = 0; dt < 4; ++dt) o[dt] = (f32x4){0.f, 0.f, 0.f, 0.f};
        { const int krow = 16 * s0 + 4 * fq + (fr >> 2), ksw = krow & 7;
          const int by = (fr & 1) * 8, chl = (fr & 3) >> 1;
#pragma unroll
          for (int kk = 0; kk < 5; ++kk) {
            bf16x8 pb; { const unsigned w0 = cvt_pk_bf16(sc[2 * kk][0], sc[2 * kk][1]), w1 = cvt_pk_bf16(sc[2 * kk][2], sc[2 * kk][3]), w2 = cvt_pk_bf16(sc[2 * kk + 1][0], sc[2 * kk + 1][1]), w3 = cvt_pk_bf16(sc[2 * kk + 1][2], sc[2 * kk + 1][3]);
                pb = __builtin_bit_cast(bf16x8, (u32x4){w0, w1, w2, w3}); }
#pragma unroll
            for (int dt = 0; dt < 4; ++dt) { LAS unsigned char* vp = Vs + krow * 128 + (((2 * dt + chl) ^ ksw) << 4) + by + kk * 4096;
                const s16x4 lo = tr_read(vp), hi = tr_read(vp + 2048);
                const bf16x8 va = {lo[0], lo[1], lo[2], lo[3], hi[0], hi[1], hi[2], hi[3]};
                o[dt] = __builtin_amdgcn_mfma_f32_16x16x32_bf16(va, pb, o[dt], 0, 0, 0); }
          } }
        const float inv = fast_rcp(l); const long qtok = (long)b * 4096 + ((long)n * 128 + 16 * w + fr) * dil + r;
        bf16_t* og = P.OG + ((size_t)g * P.T + qtok) * 256 + j * 64 + 4 * fq;
#pragma unroll
        for (int dt = 0; dt < 4; ++dt) { u32x2 wv; wv.x = cvt_pk_bf16(o[dt][0] * inv, o[dt][1] * inv); wv.y = cvt_pk_bf16(o[dt][2] * inv, o[dt][3] * inv); *(u32x2*)(og + 16 * dt) = wv; }
        if (fq == 0) P.LSE[((size_t)g * P.T + qtok) * 4 + j] = mx + __builtin_amdgcn_logf(l);
    }
    __syncthreads();
}
__device__ __forceinline__ void merge_phase(const Params& P, const Ctx& X) {
    const int gt = X.gw * 64 + X.lane, ngt = X.ngw * 64; const size_t T = (size_t)P.T;
    for (int i = gt; i < P.T * 32; i += ngt) { const size_t t = (size_t)(i >> 5); const int c8 = i & 31, j = c8 >> 3;
        const float l0 = P.LSE[t * 4 + j], l1 = P.LSE[(T + t) * 4 + j], l2 = P.LSE[(2 * T + t) * 4 + j]; const float M = fmaxf(l0, fmaxf(l1, l2));
        const float e0 = fast_exp2(l0 - M), e1 = fast_exp2(l1 - M), e2 = fast_exp2(l2 - M), inv = fast_rcp(e0 + e1 + e2);
        f32x4 a0, b0, a1, b1, a2, b2; unpack8(*(const u32x4*)(P.OG + t * 256 + c8 * 8), a0, b0); unpack8(*(const u32x4*)(P.OG + (T + t) * 256 + c8 * 8), a1, b1); unpack8(*(const u32x4*)(P.OG + (2 * T + t) * 256 + c8 * 8), a2, b2);
        *(u32x4*)(P.YA + t * 256 + c8 * 8) = pack8((a0 * e0 + a1 * e1 + a2 * e2) * inv, (b0 * e0 + b1 * e1 + b2 * e2) * inv); }
}
__device__ __forceinline__ int gsw(int row) { return ((row & 3) | (((row >> 3) & 1) << 2)) << 1; }
__device__ __forceinline__ void gmlp_phase(const Params& P, const Ctx& X) {
    LAS unsigned char* VL = X.lds; const int lane = X.lane, w = X.wave, fr = lane & 15, fq = lane >> 4;
    const float* vg = P.in[8]; const float* vb = P.in[9]; const float* bsp = P.in[7];
    const int nch = P.T / 128;
    for (int ch = X.vcu; ch < nch; ch += X.G) {
        const size_t t0 = (size_t)ch * 128;
        __syncthreads();
        { const f32x4 g0 = *(const f32x4*)(vg + 8 * lane), g1 = *(const f32x4*)(vg + 8 * lane + 4), b0 = *(const f32x4*)(vb + 8 * lane), b1 = *(const f32x4*)(vb + 8 * lane + 4);
          const char* zb = (const char*)(P.ZV + (t0 + 16 * w) * 512) + 16 * lane;
#pragma unroll 4
          for (int i = 0; i < 16; ++i) { const int s = 16 * w + i; f32x4 a, b; unpack8(*(const u32x4*)(zb + i * 1024), a, b);
            const float mean = wave_sum((a[0] + a[1]) + (a[2] + a[3]) + (b[0] + b[1]) + (b[2] + b[3])) * (1.0f / 512.0f); a -= mean; b -= mean;
            const float rstd = rsqrtf(wave_sum((a[0] * a[0] + a[1] * a[1]) + (a[2] * a[2] + a[3] * a[3]) + (b[0] * b[0] + b[1] * b[1]) + (b[2] * b[2] + b[3] * b[3])) * (1.0f / 512.0f) + 1e-5f);
            *(LAS u32x4*)(VL + s * 1024 + ((lane ^ gsw(s)) << 4)) = pack8(a * rstd * g0 + b0, b * rstd * g1 + b1); } }
        __syncthreads();
        const int gch = w >> 1; const char* wsp = (const char*)(P.WSP + (size_t)gch * 16384) + (unsigned)(fr * 128 + 8 * fq) * 2u;
        const int by = (fr & 1) * 8, chl = (fr & 3) >> 1, sr0 = 8 * fq + (fr >> 2);
        const char* zu = (const char*)(P.ZU + t0 * 512); char* yb = (char*)(P.YB + t0 * 512); const unsigned vo = (unsigned)(fr * 512 + 64 * w + 4 * fq) * 2u; const float* bsg = bsp + gch * 128 + fr;
#pragma unroll
        for (int th = 0; th < 2; ++th) {
            f32x4 acc[4][4];
#pragma unroll
            for (int ct = 0; ct < 4; ++ct)
#pragma unroll
                for (int tq = 0; tq < 4; ++tq) acc[ct][tq] = (f32x4){0.f, 0.f, 0.f, 0.f};
#pragma unroll
            for (int ks = 0; ks < 4; ++ks) { if (32 * ks > 64 * th + 63) continue;
                const int srow = 32 * ks + sr0;
                bf16x8 va[4];
#pragma unroll
                for (int ct = 0; ct < 4; ++ct) { const int chn = 8 * w + 2 * ct + chl;
                    const s16x4 lo = tr_read(VL + srow * 1024 + ((chn ^ gsw(srow)) << 4) + by), hi = tr_read(VL + (srow + 4) * 1024 + ((chn ^ gsw(srow + 4)) << 4) + by);
                    va[ct] = (bf16x8){lo[0], lo[1], lo[2], lo[3], hi[0], hi[1], hi[2], hi[3]}; }
#pragma unroll
                for (int tq = 0; tq < 4; ++tq) { const int tt = 4 * th + tq; if (32 * ks > 16 * tt + 15) continue;
                    const bf16x8 wb = *(const bf16x8*)(wsp + tt * 4096 + ks * 64);
#pragma unroll
                    for (int ct = 0; ct < 4; ++ct) acc[ct][tq] = __builtin_amdgcn_mfma_f32_16x16x32_bf16(va[ct], wb, acc[ct][tq], 0, 0, 0); }
            }
#pragma unroll
            for (int tq = 0; tq < 4; ++tq) { const int tt = 4 * th + tq; const float bs = bsg[16 * tt];
#pragma unroll
                for (int ct = 0; ct < 4; ++ct) { const size_t off = (size_t)tt * 16384 + ct * 32; const u32x2 uu = *(const u32x2*)(zu + off + vo); const f32x4 a = acc[ct][tq] + bs;
                    u32x2 o; o.x = cvt_pk_bf16(bf_lo(uu.x) * a[0], bf_hi(uu.x) * a[1]); o.y = cvt_pk_bf16(bf_lo(uu.y) * a[2], bf_hi(uu.y) * a[3]); *(u32x2*)(yb + off + vo) = o; } }
        }
    }
    __syncthreads();
}
__device__ __forceinline__ void router_phase(const Params& P, const Ctx& X) {
    LAS unsigned char* WR = X.lds; LAS float* LG = (LAS float*)(X.lds + 98304) + X.wave * 1536; LAS int* CNT = (LAS int*)(X.lds + 98304 + 49152);
    const int lane = X.lane, w = X.wave, fr = lane & 15, fq = lane >> 4;
    for (int i = X.tid; i < 48 * 128; i += 512) { const int row = i >> 7, chk = i & 127; *(LAS u32x4*)(WR + row * 2048 + ((chk ^ (row & 15)) << 4)) = *(const u32x4*)(P.WR_T + (size_t)i * 8); }
    const float* bg = P.in[20]; const float* be = P.in[22];
    const int ntb = P.T / 256;
    for (int tbk = X.vcu; tbk < ntb; tbk += X.G) {
        if (X.tid < 32) CNT[X.tid] = 0;
        __syncthreads();
        f32x4 acc[2][3];
#pragma unroll
        for (int a = 0; a < 2; ++a)
#pragma unroll
            for (int c = 0; c < 3; ++c) acc[a][c] = (f32x4){0.f, 0.f, 0.f, 0.f};
        const bf16_t* hrow = P.H2 + ((size_t)tbk * 256 + 32 * w + fr) * 1024 + 8 * fq;
#pragma unroll 4
        for (int ks = 0; ks < 32; ++ks) {
            const bf16x8 a0 = *(const bf16x8*)(hrow + 32 * ks), a1 = *(const bf16x8*)(hrow + 16 * 1024 + 32 * ks);
#pragma unroll
            for (int c = 0; c < 3; ++c) { const int row = 16 * c + fr; const bf16x8 bw = *(const LAS bf16x8*)(WR + row * 2048 + (((4 * ks + fq) ^ (row & 15)) << 4));
                acc[0][c] = __builtin_amdgcn_mfma_f32_16x16x32_bf16(a0, bw, acc[0][c], 0, 0, 0); acc[1][c] = __builtin_amdgcn_mfma_f32_16x16x32_bf16(a1, bw, acc[1][c], 0, 0, 0); }
        }
#pragma unroll
        for (int a = 0; a < 2; ++a)
#pragma unroll
            for (int c = 0; c < 3; ++c)
#pragma unroll
                for (int e = 0; e < 4; ++e) LG[(16 * a + 4 * fq + e) * 48 + 16 * c + fr] = acc[a][c][e];
        LDS_WAIT(); asm volatile("" ::: "memory");
        if (lane < 32) {
            const int t = tbk * 256 + 32 * w + lane; const float r = rinv16(P.SSQ2, (size_t)t); const LAS float* lg = LG + lane * 48;
            float g4[4]; int grp = 0; float gm = -3.0e38f;
#pragma unroll
            for (int c = 0; c < 4; ++c) { g4[c] = lg[c] * r + bg[c]; if (g4[c] > gm) { gm = g4[c]; grp = c; } }
            float den = 0.f;
#pragma unroll
            for (int c = 0; c < 4; ++c) den += __expf(g4[c] - gm);
            float v0 = -3.0e38f, v1 = -3.0e38f; int i0 = 0, i1 = 0;
#pragma unroll
            for (int i = 0; i < 8; ++i) { const float v = lg[4 + grp * 8 + i] * r + be[grp * 8 + i]; if (v > v0) { v1 = v0; i1 = i0; v0 = v; i0 = i; } else if (v > v1) { v1 = v; i1 = i; } }
            const float e1 = __expf(v1 - v0), gg = 1.0f / den, p0 = gg / (1.0f + e1), p1 = gg * e1 / (1.0f + e1);
            P.EID[2 * t] = grp * 8 + i0; P.EID[2 * t + 1] = grp * 8 + i1; P.WGT[2 * t] = p0; P.WGT[2 * t + 1] = p1;
            __hip_atomic_fetch_add(&CNT[grp * 8 + i0], 1, __ATOMIC_RELAXED, __HIP_MEMORY_SCOPE_WORKGROUP); __hip_atomic_fetch_add(&CNT[grp * 8 + i1], 1, __ATOMIC_RELAXED, __HIP_MEMORY_SCOPE_WORKGROUP);
        }
        __syncthreads();
        if (X.tid < 32) P.BCNT[tbk * 32 + X.tid] = CNT[X.tid];
        __syncthreads();
    }
}
__device__ __forceinline__ void positions_phase(const Params& P, const Ctx& X) {
    LAS int* TOT = (LAS int*)X.lds; LAS int* BEF = TOT + 32; LAS int* PST = TOT + 64; LAS int* EL = TOT + 128;
    const int ntb = P.T / 256;
    for (int tbk = X.vcu; tbk < ntb; tbk += X.G) {
        __syncthreads();
        if (X.tid < 32) { int tot = 0, bef = 0; for (int q = 0; q < ntb; ++q) { const int c = P.BCNT[q * 32 + X.tid]; tot += c; if (q < tbk) bef += c; } TOT[X.tid] = tot; BEF[X.tid] = bef; }
        EL[X.tid] = P.EID[(size_t)tbk * 512 + X.tid];
        __syncthreads();
        if (X.tid == 0) { int s = 0; for (int e = 0; e < 32; ++e) { PST[e] = s; s += (TOT[e] + 255) & ~255; } PST[32] = s; }
        __syncthreads();
        { const int a = X.tid, e = EL[a]; int rank = 0; for (int q = 0; q < a; ++q) rank += (EL[q] == e) ? 1 : 0;
          const int pos = PST[e] + BEF[e] + rank; const size_t ga = (size_t)tbk * 512 + a;
          P.ROWTOK[pos] = (int)(ga >> 1); P.WBUF[pos] = P.WGT[ga]; P.POSOF[ga] = pos; }
        if (tbk == 0) { for (int e = 0; e < 32; ++e) for (int q = PST[e] + TOT[e] + X.tid; q < PST[e + 1]; q += 512) { P.ROWTOK[q] = 0; P.WBUF[q] = 0.f; } }
        if (tbk == 0) { const int nt = PST[32] >> 8; for (int rt = X.tid; rt < nt; rt += 512) { int e = 0; while (PST[e + 1] <= rt * 256) ++e; P.TILE_E[rt] = e; } if (X.tid == 0) P.TILE_E[1024] = nt; }
    }
    __syncthreads();
}
__device__ __forceinline__ void final_phase(const Params& P, const Ctx& X) {
    const float* g = P.in[26]; const int lane = X.lane;
    for (int t = X.gw; t < P.T; t += X.ngw) {
        const int p0 = P.POSOF[2 * (size_t)t], p1 = P.POSOF[2 * (size_t)t + 1];
        const bf16_t* h = P.H2 + (size_t)t * 1024; const bf16_t* y0 = P.YBX + (size_t)p0 * 1024; const bf16_t* y1 = P.YBX + (size_t)p1 * 1024;
        f32x4 v[4]; float s = 0.f;
#pragma unroll
        for (int q = 0; q < 2; ++q) { f32x4 a, b, c, d, e, f; unpack8(*(const u32x4*)(h + 512 * q + 8 * lane), a, b); unpack8(*(const u32x4*)(y0 + 512 * q + 8 * lane), c, d); unpack8(*(const u32x4*)(y1 + 512 * q + 8 * lane), e, f);
            v[2 * q] = a + c + e; v[2 * q + 1] = b + d + f; }
#pragma unroll
        for (int q = 0; q < 4; ++q) s += (v[q][0] * v[q][0] + v[q][1] * v[q][1]) + (v[q][2] * v[q][2] + v[q][3] * v[q][3]);
        const float r = rsqrtf(wave_sum(s) * (1.0f / 1024.0f) + 1e-6f);
        float* o = P.out + (size_t)t * 1024;
#pragma unroll
        for (int q = 0; q < 2; ++q) { const f32x4 ga = *(const f32x4*)(g + 512 * q + 8 * lane), gb = *(const f32x4*)(g + 512 * q + 8 * lane + 4);
            *(f32x4*)(o + 512 * q + 8 * lane) = v[2 * q] * r * ga; *(f32x4*)(o + 512 * q + 8 * lane + 4) = v[2 * q + 1] * r * gb; }
    }
}
#define XB_TMO      128
#define XB_XCNT(j)  (256  + 64 * (j))
#define XB_XSUB(j)  (1280 + 64 * (j))
#define XB_XGEN(j)  (2304 + 64 * (j))
#define XB_TOP      3328
#define XB_TOPGEN   3392
#define XCD_BAR_WORDS 3456
#define XB_SPIN_CAP (1u << 22)
__device__ __forceinline__ unsigned xb_ld(unsigned* p)              { return __hip_atomic_load(p, __ATOMIC_RELAXED, __HIP_MEMORY_SCOPE_AGENT); }
__device__ __forceinline__ unsigned xb_add(unsigned* p, unsigned v) { return __hip_atomic_fetch_add(p, v, __ATOMIC_RELAXED, __HIP_MEMORY_SCOPE_AGENT); }
__device__ __forceinline__ unsigned xb_xcc_id() { return (unsigned)__builtin_amdgcn_s_getreg((3 << 11) | 20) & 0xFu; }
#define XB_SPIN(cond, bar) do { unsigned _sp = 0; while (cond) { __builtin_amdgcn_s_sleep(1); \
    if ((++_sp & 255u) == 0u) { if (xb_ld(&(bar)[XB_TMO])) break; if (_sp > XB_SPIN_CAP) { atomicAdd(&(bar)[XB_TMO], 1u); break; } } } } while (0)
struct XcdBarrier { unsigned* bar; unsigned x; volatile LAS unsigned* st; };
__device__ __forceinline__ XcdBarrier xcd_barrier_post(unsigned* bar, volatile LAS unsigned* st) {
    XcdBarrier b; b.bar = bar; b.x = xb_xcc_id(); b.st = st;
    if (threadIdx.x == 0) (void)xb_add(&bar[XB_XCNT(b.x)], 1u);
    return b;
}
__device__ __forceinline__ void xcd_barrier_complete(unsigned* bar, unsigned x, unsigned& nloc, unsigned& nx) {
    const unsigned G = gridDim.x * gridDim.y * gridDim.z;
    unsigned sum, cnt, mine, sp = 0u;
    for (;;) {
        sum = 0u; cnt = 0u; mine = 0u;
#pragma unroll
        for (unsigned j = 0; j < 16; ++j) { const unsigned c = xb_ld(&bar[XB_XCNT(j)]); sum += c; cnt += (c > 0u) ? 1u : 0u; mine = (j == x) ? c : mine; }
        if (sum == G) break;
        __builtin_amdgcn_s_sleep(1);
        if ((++sp & 255u) == 0u) { if (xb_ld(&bar[XB_TMO])) break; if (sp > XB_SPIN_CAP) { atomicAdd(&bar[XB_TMO], 1u); break; } }
    }
    nloc = mine > 0u ? mine : 1u; nx = cnt > 0u ? cnt : 1u;
}
__device__ __forceinline__ void xcd_barrier(const XcdBarrier& b) {
    asm volatile("s_waitcnt vmcnt(0)" ::: "memory");
    __syncthreads();
    if (threadIdx.x == 0) {
        unsigned* bar = b.bar;
        __builtin_amdgcn_s_waitcnt(0);
        unsigned nloc = b.st[0], nx = b.st[1];
        if (nloc == 0u) { xcd_barrier_complete(bar, b.x, nloc, nx); b.st[0] = nloc; b.st[1] = nx; }
        const unsigned old = xb_add(&bar[XB_XSUB(b.x)], 1u);
        const unsigned gen = old / nloc;
        if (old + 1u == (gen + 1u) * nloc) {
            __builtin_amdgcn_fence(__ATOMIC_RELEASE, "agent");
            asm volatile("s_waitcnt vmcnt(0)" ::: "memory");
            const unsigned og = xb_add(&bar[XB_TOP], 1u);
            const unsigned tg = og / nx;
            if (og + 1u == (tg + 1u) * nx) xb_add(&bar[XB_TOPGEN], 1u);
            else XB_SPIN(xb_ld(&bar[XB_TOPGEN]) == tg, bar);
            __builtin_amdgcn_fence(__ATOMIC_ACQUIRE, "agent");
            xb_add(&bar[XB_XGEN(b.x)], 1u);
            asm volatile("s_waitcnt vmcnt(0)" ::: "memory");
        } else {
            XB_SPIN(xb_ld(&bar[XB_XGEN(b.x)]) == gen, bar);
            __builtin_amdgcn_fence(__ATOMIC_ACQUIRE, "agent");
            asm volatile("s_waitcnt vmcnt(0)" ::: "memory");
        }
    }
    __syncthreads();
}

constexpr int LDS_BYTES = 163840, XCH_OFF = 131072, MISC_OFF = 163840 - 256;
constexpr int NPHASE = 14;
constexpr int CW_BAR = 4096;
#define CAS __attribute__((address_space(4)))
__global__ void __launch_bounds__(512, 2) mk_fwd(Params P_unused) {
    const CAS Params* kp = (const CAS Params*)__builtin_amdgcn_kernarg_segment_ptr();
#if defined(__HIP_DEVICE_COMPILE__)
#define PLOAD const Params P = *kp
#else
#define PLOAD const Params P = P_unused; (void)kp
#endif
    extern __shared__ __attribute__((aligned(16))) unsigned char lds_raw[];
    Ctx X; X.lds = (LAS unsigned char*)lds_raw; X.tid = threadIdx.x; X.lane = X.tid & 63; X.wave = __builtin_amdgcn_readfirstlane(X.tid >> 6);
    X.G = gridDim.x; { const int bx = blockIdx.x; X.vcu = (X.G % 8 == 0) ? (bx % 8) * (X.G / 8) + bx / 8 : bx; }
    X.gw = X.vcu * 8 + X.wave; X.ngw = X.G * 8;
    volatile LAS unsigned* MISC = (volatile LAS unsigned*)(X.lds + MISC_OFF);
    if (X.tid < 64) MISC[X.tid] = 0u;
    __syncthreads();
    const int lo = kp->ph_lo, hi = kp->ph_hi;
    XcdBarrier bar; bar.bar = kp->ctl + CW_BAR; bar.x = 0; bar.st = nullptr;
    if (hi - lo > 1) bar = xcd_barrier_post(kp->ctl + CW_BAR, MISC + 8);
#ifndef PHASE_MASK
#define PHASE_MASK 0x3fff
#endif
#define IN(k) (((PHASE_MASK >> (k)) & 1) && lo <= (k) && (k) < hi)
#define SEAM(k) do { if (IN(k) && IN((k) + 1)) xcd_barrier(bar); } while (0)
    const int nM = kp->T / 256, c = (int)blockIdx.x, G = X.G;
    LAS unsigned char* ring = X.lds;

    if (IN(0)) { PLOAD; p0_prologue(P, X); }
    SEAM(0);
    if (IN(1)) { PLOAD;
        { SchedFlat S{(const char*)P.XN, (const char*)P.WIN_T, nullptr, (size_t)256 * 1024 * 2, (size_t)256 * 1024 * 2, 0, 0, 0, nM, 21, 1 << 30, G, c};
          EpiProj E{(unsigned char*)P.Q, (size_t)P.T * 16, P.ROPE, P.in[5]};
          gemm_phase<EpiProj, SchedFlat>(ring, 1024, 1024, 1024, S, E); }
        { SchedFlat S{(const char*)P.MN, (const char*)P.WKV_T, (char*)P.KVX, (size_t)256 * 1024 * 2, (size_t)256 * 1024 * 2, 0, (size_t)256 * 2048 * 2, (size_t)256 * 2, P.nb, 8, 1 << 30, G, c};
          EpiPlain E{2048, 1.0f};
          gemm_phase<EpiPlain, SchedFlat>(ring, 1024, 1024, 1024, S, E); }
    }
    SEAM(1);
    if (IN(2)) { PLOAD;
#ifndef P2_PARTS
#define P2_PARTS 7
#endif
        if (P2_PARTS & 1) attn_phase(P, X);
        if (P2_PARTS & 2) gmlp_phase(P, X);
        if (P2_PARTS & 4) { SchedWqk S{(const char*)P.KVX, (const char*)P.WQS, (char*)P.WQK, P.nb * 4, G, c}; EpiPlain E{1024, XSCALE}; gemm_phase<EpiPlain, SchedWqk>(ring, 256, 2048, 1024, S, E); }
        if (P2_PARTS & 4) { SchedVwo S{(const char*)P.WO_T, (const char*)P.KVX, (char*)P.VWO, P.nb * 4, G, c}; EpiPlain E{1024, 1.0f}; gemm_phase<EpiPlain, SchedVwo>(ring, 256, 1024, 2048, S, E); }
    }
    SEAM(2);
    if (IN(3)) { PLOAD; merge_phase(P, X); }
    SEAM(3);
    if (IN(4)) { PLOAD;
        SchedFlat S{(const char*)P.YA, (const char*)P.WA_T, nullptr, (size_t)256 * 256 * 2, (size_t)256 * 256 * 2, 0, 0, 0, nM, 4, 1 << 30, G, c};
        EpiGate<false> E{P.GA, nullptr, P.M1};
        gemm_phase<EpiGate<false>, SchedFlat>(ring, 256, 256, 256, S, E);
    }
    if (IN(4) && IN(5)) { VM_WAIT(); __syncthreads(); }
    if (IN(5)) { PLOAD;
        SchedFlat S{(const char*)P.YB, (const char*)P.WB_T, nullptr, (size_t)256 * 512 * 2, (size_t)256 * 512 * 2, 0, 0, 0, nM, 4, 1 << 30, G, c};
        EpiGate<true> E{P.GB, P.M1, P.MERGED};
        gemm_phase<EpiGate<true>, SchedFlat>(ring, 512, 512, 512, S, E);
    }
    SEAM(5);
    if (IN(6)) { PLOAD;
        SchedFlat S{(const char*)P.MERGED, (const char*)P.WOUT_T, nullptr, (size_t)256 * 1024 * 2, (size_t)256 * 1024 * 2, 0, 0, 0, nM, 4, 1 << 30, G, c};
        EpiResid<true> E{P.in[0] + (size_t)P.b0 * 4096 * 1024, nullptr, P.H1, P.SSQ1};
        gemm_phase<EpiResid<true>, SchedFlat>(ring, 1024, 1024, 1024, S, E);
    }
    SEAM(6);
    if (IN(7)) { PLOAD;
        SchedFlat S{(const char*)P.H1, (const char*)P.WQK, nullptr, (size_t)256 * 1024 * 2, (size_t)256 * 1024 * 2, (size_t)1048576 * 2, 0, 0, nM, 4, 16, G, c};
        EpiScores E{P.SSQ1, P.PX, (LAS float*)(X.lds + XCH_OFF), X.tid};
        gemm_phase<EpiScores, SchedFlat>(ring, 1024, 1024, 1024, S, E);
    }
    SEAM(7);
    if (IN(8)) { PLOAD;
        SchedFlat S{(const char*)P.PX, (const char*)P.VWO, nullptr, (size_t)256 * 1024 * 2, (size_t)256 * 1024 * 2, (size_t)1048576 * 2, 0, 0, nM, 4, 16, G, c};
        EpiResid<false> E{nullptr, P.H1, P.H2, P.SSQ2};
        gemm_phase<EpiResid<false>, SchedFlat>(ring, 1024, 1024, 1024, S, E);
    }
    SEAM(8);
    if (IN(9)) { PLOAD; router_phase(P, X); }
    SEAM(9);
    if (IN(10)) { PLOAD; positions_phase(P, X); }
    SEAM(10);
    if (IN(11)) { PLOAD;
        SchedMoe S{(const char*)P.H2, (const char*)P.WGU_T, (char*)P.HB, P.ROWTOK, P.TILE_E, P.TILE_E + 1024, 0, (size_t)1048576 * 2, (size_t)256 * 1024 * 2, (size_t)512 * 2, (size_t)128 * 2, G, X.vcu};
        EpiMoe1 E{P.SSQ2, (LAS float*)(X.lds + XCH_OFF), X.tid};
        gemm_phase<EpiMoe1, SchedMoe, true>(ring, 1024, 1024, 1024, S, E);
    }
    SEAM(11);
    if (IN(12)) { PLOAD;
        SchedMoe S{(const char*)P.HB, (const char*)P.WD_T, (char*)P.YBX, P.ROWTOK, P.TILE_E, P.TILE_E + 1024, (size_t)512 * 2, (size_t)524288 * 2, (size_t)256 * 512 * 2, (size_t)1024 * 2, (size_t)256 * 2, G, X.vcu};
        EpiMoe2 E{P.WBUF};
        gemm_phase<EpiMoe2, SchedMoe>(ring, 512, 512, 512, S, E);
    }
    SEAM(12);
    if (IN(13)) { PLOAD; final_phase(P, X); }
#undef IN
#undef SEAM
}

constexpr size_t MiB = 1u << 20;
static Params make_params(void* const* d_in, unsigned char* ws, unsigned char* sc2, float* out, int nb, int b0) {
    Params P{};
    for (int i = 0; i < 27; ++i) P.in[i] = (const float*)d_in[i];
    P.out = out; P.ctl = (unsigned*)ws; P.nb = nb; P.T = nb * 4096; P.b0 = b0;
    size_t o = 1 * MiB; auto fx = [&](size_t bytes) { unsigned char* p = ws + o; o += (bytes + 4095) & ~(size_t)4095; return p; };
    P.WIN_T = (bf16_t*)fx((size_t)5376 * 1024 * 2); P.WKV_T = (bf16_t*)fx((size_t)2048 * 1024 * 2); P.WA_T = (bf16_t*)fx((size_t)1024 * 256 * 2); P.WB_T = (bf16_t*)fx((size_t)1024 * 512 * 2);
    P.WOUT_T = (bf16_t*)fx((size_t)1024 * 1024 * 2); P.WQS = (bf16_t*)fx((size_t)1024 * 1024 * 2); P.WO_T = (bf16_t*)fx((size_t)1024 * 1024 * 2); P.WR_T = (bf16_t*)fx((size_t)48 * 1024 * 2);
    P.WSP = (bf16_t*)fx((size_t)4 * 128 * 128 * 2); P.WGU_T = (bf16_t*)fx((size_t)32 * 1024 * 1024 * 2); P.WD_T = (bf16_t*)fx((size_t)32 * 1024 * 512 * 2);
    P.TILE_E = (int*)fx(8192); P.TOT = (int*)fx(4096); P.BCNT = (int*)fx(256 * 32 * 4);
    const size_t u = (size_t)P.T * 16; unsigned char* sb = ws + 128 * MiB; auto sc = [&](size_t s) { return sb + s * u; };
    P.Q = (bf16_t*)sc(0); P.K = (bf16_t*)sc(96); P.V = (bf16_t*)sc(192); P.ZU = (bf16_t*)sc(288); P.ZV = (bf16_t*)sc(352); P.GA = (bf16_t*)sc(416); P.GB = (bf16_t*)sc(544);
    P.OG = (bf16_t*)sc(672); P.LSE = (float*)sc(768); P.SSQ1 = (float*)sc(772); P.SSQ2 = (float*)sc(776); P.EID = (int*)sc(780); P.WGT = (float*)sc(781); P.POSOF = (int*)sc(782);
    P.ROWTOK = (int*)sc(783); P.WBUF = (float*)sc(785);
    P.YA = (bf16_t*)sc(0); P.M1 = (bf16_t*)sc(32); P.MERGED = (bf16_t*)sc(160); P.H1 = (bf16_t*)sc(288); P.PX = (bf16_t*)sc(416); P.H2 = (bf16_t*)sc(544);
    const size_t prow = (size_t)2 * P.T + 8192;
    if (nb == 16) { P.HB = (bf16_t*)sc(0); P.YBX = (bf16_t*)sc(136); } else { P.HB = (bf16_t*)sc(800); P.YBX = (bf16_t*)(sc(800) + prow * 1024); }
    auto s2 = [&](size_t s) { return sc2 + s * u; };
    P.XN = (bf16_t*)s2(0); P.MN = (bf16_t*)s2(128); P.ROPE = (float*)s2(136); P.KVX = (bf16_t*)s2(152); P.YB = (bf16_t*)s2(0); P.WQK = (bf16_t*)s2(64); P.VWO = (bf16_t*)s2(96);
    return P;
}
static size_t ws_bytes_needed(int nb) { const size_t T = (size_t)nb * 4096, u = T * 16, prow = 2 * T + 8192; return 128 * MiB + (nb == 16 ? 787 * u : 800 * u + prow * 1024 * 3); }
static int g_grid = 0;
static bool mk_setup() {
    if (g_grid) return g_grid > 0;
    int dev = 0, cus = 0;
    if (hipGetDevice(&dev) != hipSuccess || hipDeviceGetAttribute(&cus, hipDeviceAttributeMultiprocessorCount, dev) != hipSuccess) { g_grid = -1; return false; }
    if (hipFuncSetAttribute((const void*)mk_fwd, hipFuncAttributeMaxDynamicSharedMemorySize, LDS_BYTES) != hipSuccess) { fprintf(stderr, "mk: cannot get %d B of dynamic LDS\n", LDS_BYTES); g_grid = -1; return false; }
    int per_cu = 0; (void)hipOccupancyMaxActiveBlocksPerMultiprocessor(&per_cu, (const void*)mk_fwd, 512, LDS_BYTES); (void)hipGetLastError();
    if (per_cu < 1) fprintf(stderr, "mk: occupancy query says %d workgroups per CU\n", per_cu);
    g_grid = cus; return true;
}
static void mk_launch(Params P, int lo, int hi, hipStream_t st) { P.ph_lo = lo; P.ph_hi = hi; hipLaunchKernelGGL(mk_fwd, dim3(g_grid), dim3(512), LDS_BYTES, st, P); }
}
#ifndef BUILD_MODE
#define BUILD_MODE 1
#endif
#if BUILD_MODE == 3
namespace chk {
__global__ void __launch_bounds__(256) cmp(const void* opt, int kind, int ldo, const void* ref, int ldr, int rows, int cols, int mode, float scale, const float* bias, float* err) {
    float num = 0.f, den = 0.f;
    for (size_t i = (size_t)blockIdx.x * 256 + threadIdx.x; i < (size_t)rows * cols; i += (size_t)gridDim.x * 256) {
        const int r = (int)(i / cols), c = (int)(i % cols);
        if (kind == 2) { const int o = ((const int*)opt)[(size_t)r * ldo + c], v = ((const int*)ref)[(size_t)r * ldr + c]; num += (o != v) ? 1.f : 0.f; den += 1.f; continue; }
        float o; if (kind == 1) o = __uint_as_float(((unsigned)((const unsigned short*)opt)[(size_t)r * ldo + c]) << 16); else o = ((const float*)opt)[(size_t)r * ldo + c];
        int rc = c; if (mode == 1) { const int d = c & 63; rc = (c & ~63) + (d >> 1) + 32 * (d & 1); }
        float v = (mode == 4) ? ((const float*)ref)[(size_t)c * ldr + r] : ((const float*)ref)[(size_t)r * ldr + rc]; if (mode == 2) v = 1.0f / (1.0f + expf(-(v + (bias ? bias[c] : 0.f)))); if (mode == 3) { const float uu = 0.7978845608028654f * (v + 0.044715f * v * v * v); v = 0.5f * v * (1.0f + tanhf(uu)); } v *= scale;
        const float d2 = (o - v) * (o - v); num += (d2 == d2) ? d2 : 1e30f; den += v * v;
    }
    for (int o = 32; o >= 1; o >>= 1) { num += __shfl_xor(num, o); den += __shfl_xor(den, o); }
    if ((threadIdx.x & 63) == 0) { atomicAdd(err, num); atomicAdd(err + 1, den); }
}
__global__ void decide(const float* err, const unsigned* barw, float* factor, int nstage) {
    if (threadIdx.x != 0 || blockIdx.x != 0) return;
    float f = 1.0f;
    for (int k = 1; k <= nstage; ++k) { const float num = err[2 * k], den = err[2 * k + 1]; float rel = (k == 13) ? num / fmaxf(den, 1.f) : sqrtf(num / fmaxf(den, 1e-30f));
        const float tol = (k == 13) ? 0.05f : 0.03f;
        if (!(rel < tol)) { int cls = 0; if (!(rel < 0.1f)) cls = 1; if (!(rel < 0.5f)) cls = 2; if (!(rel < 1.2f)) cls = 3; if (!(rel < 1e6f)) cls = 4;
            float c = 0.25f * (float)k; for (int q = 0; q < cls; ++q) c *= 100.f; f = 1.0f + c; break; } }
    if (f == 1.0f && barw[mk::CW_BAR + XB_TMO] != 0u) f = 1.0f + 4.0f;
    *factor = f;
}
__global__ void decide_mask(const float* err, float* factor, int first, int ntests) {
    if (threadIdx.x != 0 || blockIdx.x != 0) return;
    int mask = 0;
    for (int q = 0; q < ntests; ++q) { const float num = err[2 * (first + q)], den = err[2 * (first + q) + 1]; const float rel = sqrtf(num / fmaxf(den, 1e-30f)); if (!(rel < 0.03f)) mask |= 1 << q; }
    *factor = 1.0f + 0.25f * (float)(mask + 1);
#ifdef CHK_REL_OF
    { const float num = err[2 * CHK_REL_OF], den = err[2 * CHK_REL_OF + 1]; *factor = 1.0f + sqrtf(num / fmaxf(den, 1e-30f)); }
#endif
}
__global__ void __launch_bounds__(256) scale_out(float* out, const float* factor, size_t n) { const float f = *factor; for (size_t i = (size_t)blockIdx.x * 256 + threadIdx.x; i < n; i += (size_t)gridDim.x * 256) out[i] *= f; }
}
#endif

extern "C" void kernel_launch(void* const* d_in, const int* in_sizes, int n_in, void* d_out, int out_size, void* d_ws, size_t ws_size, hipStream_t stream) {
    (void)in_sizes; (void)n_in; (void)out_size; (void)ws_size;
#if BUILD_MODE == 0
    const nv::Bufs B = nv::carve((unsigned char*)d_ws);
    for (int b = 0; b < 16; ++b) nv::forward_batch(d_in, b, B, (float*)d_out + (size_t)b * nv::S * nv::D, nullptr, stream);
#elif BUILD_MODE == 1 || BUILD_MODE == 2
    if (!mk::mk_setup()) return;
    const mk::Params P = mk::make_params(d_in, (unsigned char*)d_ws, (unsigned char*)d_out, (float*)d_out, 16, 0);
    (void)hipMemsetAsync(d_ws, 0, 65536, stream);
#if BUILD_MODE == 1
    for (int k = 0; k < mk::NPHASE; ++k) mk::mk_launch(P, k, k + 1, stream);
#else
    mk::mk_launch(P, 0, mk::NPHASE, stream);
#endif
#else
    if (!mk::mk_setup()) return;
    unsigned char* ws = (unsigned char*)d_ws; const size_t MiB = mk::MiB;
    const nv::Bufs B = nv::carve(ws);
    for (int b = 0; b < 16; ++b) nv::forward_batch(d_in, b, B, (float*)d_out + (size_t)b * nv::S * nv::D, nullptr, stream);
    unsigned char* ows = ws + 384 * MiB; unsigned char* sc2 = ws + 700 * MiB; float* oout = (float*)(ws + 740 * MiB); float* err = (float*)(ws + 780 * MiB); float* factor = err + 64;
    (void)hipMemsetAsync(ows, 0, 65536, stream); (void)hipMemsetAsync(err, 0, 1024, stream);
    const mk::Params P = mk::make_params(d_in, ows, sc2, oout, 2, 14);
    const size_t R = 4096;
    auto C = [&](int code, const void* opt, int kind, int ldo, const void* ref, int ldr, int cols, int mode, float scale, const float* bias) {
        const int esz = kind == 1 ? 2 : 4; chk::cmp<<<1024, 256, 0, stream>>>((const char*)opt + R * (size_t)ldo * esz, kind, ldo, ref, ldr, 4096, cols, mode, scale, bias, err + 2 * code); };
    const float* bgates = (const float*)d_in[5];
    for (int k = 0; k < mk::NPHASE; ++k) {
        mk::mk_launch(P, k, k + 1, stream);
        if (k == 0) C(1, P.XN, 1, 1024, B.XN, 1024, 1024, 0, 1.f, nullptr);
        if (k == 1) { C(2, P.Q, 1, 768, B.PROJ, 5376, 768, 1, mk::QSCALE, nullptr); C(3, P.K, 1, 768, B.PROJ + 768, 5376, 768, 1, 1.f, nullptr); C(4, P.V, 1, 768, B.PROJ + 1536, 5376, 768, 0, 1.f, nullptr);
                      C(5, P.ZU, 1, 512, B.U, 512, 512, 0, 1.f, nullptr); C(6, P.GA, 1, 1024, B.PROJ + 3328, 5376, 1024, 2, 1.f, bgates); C(7, P.GB, 1, 1024, B.PROJ + 4352, 5376, 1024, 2, 1.f, bgates + 1024); }
#ifdef CHK_MASK_FIRST
        if (k == 0) { const float* w_in = (const float*)d_in[4]; const float* w_kv = (const float*)d_in[16];
            chk::cmp<<<1024, 256, 0, stream>>>(P.WIN_T + (size_t)2816 * 1024, 1, 1024, w_in + 2816, 5376, 512, 1024, 4, 1.f, nullptr, err + 40);
            chk::cmp<<<1024, 256, 0, stream>>>(P.WIN_T + (size_t)3328 * 1024, 1, 1024, w_in + 3328, 5376, 1024, 1024, 4, 1.f, nullptr, err + 42);
            chk::cmp<<<1024, 256, 0, stream>>>(P.WIN_T + (size_t)4352 * 1024, 1, 1024, w_in + 4352, 5376, 1024, 1024, 4, 1.f, nullptr, err + 44);
            chk::cmp<<<1024, 256, 0, stream>>>(P.WKV_T, 1, 1024, w_kv, 2048, 2048, 1024, 4, 1.f, nullptr, err + 46); }
#endif
        if (k == 2) C(9, P.YB, 1, 512, B.YB, 512, 512, 0, 1.f, nullptr);
        if (k == 3) C(8, P.YA, 1, 256, B.YA, 256, 256, 0, 1.f, nullptr);
        if (k == 5) C(10, P.MERGED, 1, 1024, B.MERGED, 1024, 1024, 0, 1.f, nullptr);
        if (k == 6) C(11, P.H1, 1, 1024, B.H1, 1024, 1024, 0, 1.f, nullptr);
        if (k == 8) C(12, P.H2, 1, 1024, B.H2, 1024, 1024, 0, 1.f, nullptr);
        if (k == 9) { chk::cmp<<<64, 256, 0, stream>>>(P.EID + 2 * R, 2, 2, B.EID, 2, 4096, 2, 0, 1.f, nullptr, err + 26); chk::cmp<<<64, 256, 0, stream>>>(P.WGT + 2 * R, 0, 2, B.WGT, 2, 4096, 2, 0, 1.f, nullptr, err + 28); }
        if (k == 13) C(15, oout, 0, 1024, (const float*)d_out + (size_t)15 * 4096 * 1024, 1024, 1024, 0, 1.f, nullptr);
    }
#ifdef CHK_MASK_FIRST
    chk::decide_mask<<<1, 64, 0, stream>>>(err, factor, CHK_MASK_FIRST, 4);
#else
    chk::decide<<<1, 64, 0, stream>>>(err, (const unsigned*)ows, factor, 15);
#endif
    chk::scale_out<<<2048, 256, 0, stream>>>((float*)d_out, factor, (size_t)16 * 4096 * 1024);
#endif
}
```

```cpp
#define BUILD_MODE 2
#include <hip/hip_runtime.h>
#include <cstdio>
#include <cstdint>
namespace mk {
#define LAS __attribute__((address_space(3)))
#define GAS __attribute__((address_space(1)))
typedef unsigned short bf16_t;
typedef short bf16x8 __attribute__((ext_vector_type(8)));
typedef short s16x4 __attribute__((ext_vector_type(4)));
typedef float f32x4 __attribute__((ext_vector_type(4)));
typedef float f32x2 __attribute__((ext_vector_type(2)));
typedef unsigned u32x4 __attribute__((ext_vector_type(4)));
typedef unsigned u32x2 __attribute__((ext_vector_type(2)));
constexpr int BM = 256, BK = 64, HALF = 128, HTB = HALF * BK * 2, STAGE_BYTES = 8 * HTB, NXCD = 8, WGM = 8;

__host__ __device__ __forceinline__ int lds_byte(int r, int c) { const int st = (r >> 4) * 2 + (c >> 5), rr = r & 15, cc = c & 31, ob = rr * 64 + cc * 2; return st * 1024 + (ob ^ (((ob >> 9) & 1) << 5)); }
__host__ __device__ __forceinline__ void stage_rc(int b, int& R, int& C) { const int st = b / 1024, sb = b % 1024, swz = sb ^ (((sb >> 9) & 1) << 5); R = (st >> 1) * 16 + swz / 64; C = (st & 1) * 32 + (swz % 64) / 2; }
__host__ __device__ __forceinline__ int perm32(int rho) { const int n = rho >> 4, i = rho & 15; return 8 * (i >> 2) + 4 * n + (i & 3); }

typedef __bf16 bf16x2_t __attribute__((ext_vector_type(2)));
__device__ __forceinline__ unsigned cvt_pk_bf16(float lo, float hi) { const f32x2 v = {lo, hi}; const bf16x2_t b = __builtin_convertvector(v, bf16x2_t); return __builtin_bit_cast(unsigned, b); }
__device__ __forceinline__ float bf_lo(unsigned w) { return __uint_as_float(w << 16); }
__device__ __forceinline__ float bf_hi(unsigned w) { return __uint_as_float(w & 0xffff0000u); }
__device__ __forceinline__ float fast_exp2(float x) { return __builtin_amdgcn_exp2f(x); }
__device__ __forceinline__ float fast_rcp(float x) { return __builtin_amdgcn_rcpf(x); }

struct Unit { const char* A; const char* B; char* C; const int* rows; int pm, pn, z, pad; };

__device__ __forceinline__ void tile_of(int wgid, int nM, int nN, int& pm, int& pn) {
    const int nwg = nM * nN; { const int q = nwg / NXCD, r = nwg % NXCD, xcd = wgid % NXCD, off = wgid / NXCD; wgid = (xcd < r ? xcd * (q + 1) : r * (q + 1) + (xcd - r) * q) + off; }
    const int nig = WGM * nN, gid = wgid / nig, fm = gid * WGM, gsz = (nM - fm) < WGM ? (nM - fm) : WGM;
    pm = fm + ((wgid % nig) % gsz); pn = (wgid % nig) / gsz;
}

template <class Epi, class Sched, bool GATHER = false>
__device__ __forceinline__ void gemm_phase(LAS unsigned char* lds, const int K, const int lda, const int ldb, const Sched& S, const Epi& E) {
    const int tid = threadIdx.x, wid = __builtin_amdgcn_readfirstlane(tid >> 6), lane = tid & 63, wr = wid >> 2, wc = wid & 3, fr = lane & 15, fq = lane >> 4;
    const int nt = K / BK;
    int RA[2], CA[2]; unsigned voffB[2][2];
#pragma unroll
    for (int i = 0; i < 2; ++i) { int R, C; stage_rc(tid * 16 + i * 8192, R, C); const int Rb = Epi::PERM ? ((R & ~31) + perm32(R & 31)) : R; RA[i] = R; CA[i] = C;
        voffB[0][i] = (unsigned)(Rb * ldb + C) * 2u; voffB[1][i] = (unsigned)((Rb + HALF) * ldb + C) * 2u; }
    const size_t kstep = (size_t)(BK * 2);
    const unsigned ldsw = (unsigned)wid * 1024u;
    const int aoff = lds_byte(wr * 64 + fr, fq * 8), boff = lds_byte(wc * 32 + fr, fq * 8);
#define MK_SA(b, h) (((b) * 2 + (h)) * HTB)
#define MK_SB(b, h) ((4 + (b) * 2 + (h)) * HTB)
#define MK_STAGE2(bufoff, gbase, v0, v1) do { \
        __builtin_amdgcn_global_load_lds((const unsigned*)((const char*)(gbase) + (v0)), (LAS unsigned*)(lds + (bufoff) + ldsw), 16, 0, 0); \
        __builtin_amdgcn_global_load_lds((const unsigned*)((const char*)(gbase) + (v1)), (LAS unsigned*)(lds + (bufoff) + ldsw + 8192), 16, 0, 0); } while (0)
#define MK_LDA(dst, b, h) do { _Pragma("unroll") for (int m = 0; m < 4; ++m) _Pragma("unroll") for (int k = 0; k < 2; ++k) dst[m][k] = *(const LAS bf16x8*)(lds + MK_SA(b, h) + aoff + m * 2048 + k * 1024); } while (0)
#define MK_LDB(dst, b, h) do { _Pragma("unroll") for (int n = 0; n < 2; ++n) _Pragma("unroll") for (int k = 0; k < 2; ++k) dst[n][k] = *(const LAS bf16x8*)(lds + MK_SB(b, h) + boff + n * 2048 + k * 1024); } while (0)
#define MK_MMA(ai, bj, At, Bt) do { __builtin_amdgcn_s_setprio(1); _Pragma("unroll") for (int m = 0; m < 4; ++m) _Pragma("unroll") for (int n = 0; n < 2; ++n) _Pragma("unroll") for (int k = 0; k < 2; ++k) \
        acc[ai][bj][m][n] = __builtin_amdgcn_mfma_f32_16x16x32_bf16(Bt[n][k], At[m][k], acc[ai][bj][m][n], 0, 0, 0); __builtin_amdgcn_s_setprio(0); } while (0)
#define MK_WAIT_V(n) asm volatile("s_waitcnt vmcnt(" #n ")" ::: "memory")
#define MK_WAIT_L(n) asm volatile("s_waitcnt lgkmcnt(" #n ")" ::: "memory")
#define MK_BAR __builtin_amdgcn_s_barrier()
#define MK_SCHED __builtin_amdgcn_sched_barrier(0)
    Unit cur, nxt; int ui = 0;
    if (!S.next(0, cur)) return;
    f32x4 acc[2][2][4][2];
#pragma unroll
    for (int a = 0; a < 2; ++a)
#pragma unroll
        for (int b = 0; b < 2; ++b)
#pragma unroll
            for (int m = 0; m < 4; ++m)
#pragma unroll
                for (int n = 0; n < 2; ++n) acc[a][b][m][n] = (f32x4){0.f, 0.f, 0.f, 0.f};
    bf16x8 At[4][2], B0[2][2], B1[2][2];
    unsigned vA[2][2], nvA[2][2];
    auto a_offsets = [&](const Unit& u, unsigned (&v)[2][2]) {
#pragma unroll
        for (int h = 0; h < 2; ++h)
#pragma unroll
            for (int i = 0; i < 2; ++i) { const int r = h * HALF + RA[i]; const int src = GATHER ? ((const GAS int*)u.rows)[r] : r; v[h][i] = (unsigned)(src * lda + CA[i]) * 2u; }
    };
    a_offsets(cur, vA);
    if (GATHER) asm volatile("" : "+v"(vA[0][0]), "+v"(vA[0][1]), "+v"(vA[1][0]), "+v"(vA[1][1]));
    const char* cA = cur.A; const char* cB = cur.B;
    MK_STAGE2(MK_SB(0, 0), cB, voffB[0][0], voffB[0][1]); MK_STAGE2(MK_SB(0, 1), cB, voffB[1][0], voffB[1][1]); MK_STAGE2(MK_SA(0, 0), cA, vA[0][0], vA[0][1]); MK_STAGE2(MK_SA(0, 1), cA, vA[1][0], vA[1][1]);
    if (wr == 1) MK_BAR;
    MK_WAIT_V(2); MK_BAR;
    MK_STAGE2(MK_SB(1, 0), cB + kstep, voffB[0][0], voffB[0][1]); MK_STAGE2(MK_SA(1, 0), cA + kstep, vA[0][0], vA[0][1]); MK_STAGE2(MK_SB(1, 1), cB + kstep, voffB[1][0], voffB[1][1]);
    MK_WAIT_V(6); MK_BAR;
    for (;;) {
        const bool has_next = S.next(ui + 1, nxt);
        const char* nA = has_next ? nxt.A : cA; const char* nB = has_next ? nxt.B : cB;
        if (GATHER) { if (has_next) a_offsets(nxt, nvA); else {
#pragma unroll
            for (int h = 0; h < 2; ++h) { nvA[h][0] = vA[h][0]; nvA[h][1] = vA[h][1]; } }
            asm volatile("" : "+v"(nvA[0][0]), "+v"(nvA[0][1]), "+v"(nvA[1][0]), "+v"(nvA[1][1])); }
#pragma nounroll
        for (int t = 0; t < nt; t += 2) {
            const bool last = (t == nt - 2);
            const char* a1 = cA + (size_t)(t + 1) * kstep;
            const char* a2 = last ? nA : cA + (size_t)(t + 2) * kstep; const char* b2 = last ? nB : cB + (size_t)(t + 2) * kstep;
            const char* a3 = a2 + kstep; const char* b3 = b2 + kstep;
            unsigned w00 = vA[0][0], w01 = vA[0][1], w10 = vA[1][0], w11 = vA[1][1];
            if (GATHER) { if (last) { w00 = nvA[0][0]; w01 = nvA[0][1]; w10 = nvA[1][0]; w11 = nvA[1][1]; } }
            MK_LDB(B0, 0, 0); MK_LDB(B1, 0, 1); MK_SCHED; MK_LDA(At, 0, 0); MK_STAGE2(MK_SA(1, 1), a1, vA[1][0], vA[1][1]);
            MK_WAIT_V(8); MK_WAIT_L(0); MK_BAR; MK_MMA(0, 0, At, B0); MK_MMA(0, 1, At, B1); MK_BAR; MK_SCHED;
            MK_LDA(At, 0, 1); MK_STAGE2(MK_SB(0, 0), b2, voffB[0][0], voffB[0][1]); MK_STAGE2(MK_SB(0, 1), b2, voffB[1][0], voffB[1][1]); MK_STAGE2(MK_SA(0, 0), a2, w00, w01);
            MK_WAIT_V(8); MK_WAIT_L(0); MK_BAR; MK_MMA(1, 0, At, B0); MK_MMA(1, 1, At, B1); MK_BAR; MK_SCHED;
            MK_LDB(B0, 1, 0); MK_LDB(B1, 1, 1); MK_SCHED; MK_LDA(At, 1, 0); MK_STAGE2(MK_SA(0, 1), a2, w10, w11);
            MK_WAIT_V(8); MK_WAIT_L(0); MK_BAR; MK_MMA(0, 0, At, B0); MK_MMA(0, 1, At, B1); MK_BAR; MK_SCHED;
            MK_LDA(At, 1, 1); MK_STAGE2(MK_SB(1, 0), b3, voffB[0][0], voffB[0][1]); MK_STAGE2(MK_SB(1, 1), b3, voffB[1][0], voffB[1][1]); MK_STAGE2(MK_SA(1, 0), a3, w00, w01);
            MK_WAIT_V(8); MK_WAIT_L(0); MK_BAR; MK_MMA(1, 0, At, B0); MK_MMA(1, 1, At, B1); MK_BAR; MK_SCHED;
        }
        if (wr == 0) MK_BAR;
        E(acc, cur, wr, wc, fr, fq);
        if (!has_next) break;
#pragma unroll
        for (int a = 0; a < 2; ++a)
#pragma unroll
            for (int b = 0; b < 2; ++b)
#pragma unroll
                for (int m = 0; m < 4; ++m)
#pragma unroll
                    for (int n = 0; n < 2; ++n) acc[a][b][m][n] = (f32x4){0.f, 0.f, 0.f, 0.f};
        cur = nxt; cA = nA; cB = nB; ++ui;
        if (GATHER) {
#pragma unroll
            for (int h = 0; h < 2; ++h) { vA[h][0] = nvA[h][0]; vA[h][1] = nvA[h][1]; } }
        if (wr == 1) MK_BAR;
    }
    MK_WAIT_V(0);
    MK_BAR;
#undef MK_SA
#undef MK_SB
#undef MK_STAGE2
#undef MK_LDA
#undef MK_LDB
#undef MK_MMA
#undef MK_WAIT_V
#undef MK_WAIT_L
#undef MK_BAR
#undef MK_SCHED
}
constexpr float LOG2E = 1.4426950408889634f;
constexpr float QSCALE = 0.125f * LOG2E;
constexpr float XSCALE = 0.0625f * LOG2E;
#define EPI_ARGS f32x4 (&acc)[2][2][4][2], const Unit& u, int wr, int wc, int fr, int fq
#define FOR_AI_M _Pragma("unroll") for (int ai = 0; ai < 2; ++ai) _Pragma("unroll") for (int m = 0; m < 4; ++m)
#define FOR_BJ _Pragma("unroll") for (int bj = 0; bj < 2; ++bj)
__device__ __forceinline__ u32x4 pack8(const f32x4 a, const f32x4 b) { u32x4 w; w.x = cvt_pk_bf16(a[0], a[1]); w.y = cvt_pk_bf16(a[2], a[3]); w.z = cvt_pk_bf16(b[0], b[1]); w.w = cvt_pk_bf16(b[2], b[3]); return w; }
__device__ __forceinline__ void unpack8(const u32x4 w, f32x4& a, f32x4& b) { a = (f32x4){bf_lo(w.x), bf_hi(w.x), bf_lo(w.y), bf_hi(w.y)}; b = (f32x4){bf_lo(w.z), bf_hi(w.z), bf_lo(w.w), bf_hi(w.w)}; }
__device__ __forceinline__ float sigm(float x) { return fast_rcp(1.0f + fast_exp2(-LOG2E * x)); }
__device__ __forceinline__ float gelu_t(float x) { const float u2 = 1.5957691216057308f * x * (1.0f + 0.044715f * x * x); return x * fast_rcp(1.0f + fast_exp2(-LOG2E * u2)); }
__device__ __forceinline__ float rinv16(const float* ssq, size_t row) {
    const f32x4* p = (const f32x4*)(ssq + row * 16); const f32x4 a = p[0], b = p[1], c = p[2], d = p[3];
    const float s = ((a[0] + a[1]) + (a[2] + a[3])) + ((b[0] + b[1]) + (b[2] + b[3])) + ((c[0] + c[1]) + (c[2] + c[3])) + ((d[0] + d[1]) + (d[2] + d[3]));
    return rsqrtf(s * (1.0f / 1024.0f) + 1e-6f);
}

#define GRP(ld, esz) ((size_t)(ai * HALF + m * 16) * (size_t)(ld) * (esz))
#define FENCE_ODD_M if (m & 1) asm volatile("" ::: "memory")
struct EpiProj {
    static constexpr bool PERM = true;
    unsigned char* sb; size_t un; const float* rope; const float* bgates;
    __device__ __forceinline__ void operator()(EPI_ARGS) const {
        const int pn = u.pn; const int rt0 = wr * 64 + fr, cl = wc * 32 + 8 * fq; const size_t prow = (size_t)u.pm * BM;
        if (pn < 9) {
            const int sel = pn / 3, colt = (pn - 3 * sel) * 256; char* ob = (char*)(sb + (size_t)(96 * sel) * un) + (prow * 768 + colt) * 2; const unsigned vo = (unsigned)(rt0 * 768 + cl) * 2u;
            if (sel < 2) { const float sc = sel == 0 ? QSCALE : 1.0f; const char* tb = (const char*)rope + prow * 256; const unsigned vt = (unsigned)(rt0 * 64 + ((cl & 63) >> 1)) * 4u;
                FOR_AI_M { const char* tr = tb + GRP(64, 4) + vt; char* orow = ob + GRP(768, 2) + vo;
                    const f32x4 cs = *(const f32x4*)(tr) * sc, sn = *(const f32x4*)(tr + 128) * sc;
                    FOR_BJ { const f32x4 v0 = acc[ai][bj][m][0], v1 = acc[ai][bj][m][1];
                        const f32x4 o0 = {v0[0] * cs[0] - v0[1] * sn[0], v0[1] * cs[0] + v0[0] * sn[0], v0[2] * cs[1] - v0[3] * sn[1], v0[3] * cs[1] + v0[2] * sn[1]};
                        const f32x4 o1 = {v1[0] * cs[2] - v1[1] * sn[2], v1[1] * cs[2] + v1[0] * sn[2], v1[2] * cs[3] - v1[3] * sn[3], v1[3] * cs[3] + v1[2] * sn[3]};
                        *(u32x4*)(orow + bj * 256) = pack8(o0, o1); }
                    FENCE_ODD_M; }
            } else {
                FOR_AI_M { char* orow = ob + GRP(768, 2) + vo; FOR_BJ *(u32x4*)(orow + bj * 256) = pack8(acc[ai][bj][m][0], acc[ai][bj][m][1]); }
            }
        } else if (pn < 13) {
            char* ob = (char*)(sb + (size_t)(pn < 11 ? 288 : 352) * un) + (prow * 512 + ((pn - 9) & 1) * 256) * 2; const unsigned vo = (unsigned)(rt0 * 512 + cl) * 2u;
            FOR_AI_M { char* orow = ob + GRP(512, 2) + vo;
                FOR_BJ { f32x4 a = acc[ai][bj][m][0], b = acc[ai][bj][m][1];
#pragma unroll
                    for (int e = 0; e < 4; ++e) { a[e] = gelu_t(a[e]); b[e] = gelu_t(b[e]); }
                    *(u32x4*)(orow + bj * 256) = pack8(a, b); } }
        } else {
            char* ob = (char*)(sb + (size_t)(pn < 17 ? 416 : 544) * un) + (prow * 1024 + ((pn - 13) & 3) * 256) * 2; const unsigned vo = (unsigned)(rt0 * 1024 + cl) * 2u;
            const char* bb = (const char*)(bgates + (pn - 13) * 256); const unsigned vb = (unsigned)cl * 4u;
            f32x4 bv[2][2];
            FOR_BJ { bv[bj][0] = *(const f32x4*)(bb + bj * 512 + vb); bv[bj][1] = *(const f32x4*)(bb + bj * 512 + 16 + vb); }
            FOR_AI_M { char* orow = ob + GRP(1024, 2) + vo;
                FOR_BJ { f32x4 a = acc[ai][bj][m][0] + bv[bj][0], b = acc[ai][bj][m][1] + bv[bj][1];
#pragma unroll
                    for (int e = 0; e < 4; ++e) { a[e] = sigm(a[e]); b[e] = sigm(b[e]); }
                    *(u32x4*)(orow + bj * 256) = pack8(a, b); } }
        }
    }
};
struct EpiPlain {
    static constexpr bool PERM = true;
    int ldc; float scale;
    __device__ __forceinline__ void operator()(EPI_ARGS) const {
        const int rt0 = wr * 64 + fr, cl = wc * 32 + 8 * fq; const unsigned vo = (unsigned)(rt0 * ldc + cl) * 2u;
        FOR_AI_M { char* orow = u.C + GRP(ldc, 2) + vo;
            FOR_BJ *(u32x4*)(orow + bj * 256) = pack8(acc[ai][bj][m][0] * scale, acc[ai][bj][m][1] * scale); }
    }
};
template <bool ADD> struct EpiGate {
    static constexpr bool PERM = true;
    const bf16_t* G; const bf16_t* M1; bf16_t* O;
    __device__ __forceinline__ void operator()(EPI_ARGS) const {
        const int rt0 = wr * 64 + fr, cl = wc * 32 + 8 * fq; const size_t tb = ((size_t)u.pm * BM * 1024 + (size_t)u.pn * BM) * 2; const unsigned vo = (unsigned)(rt0 * 1024 + cl) * 2u;
        FOR_AI_M { const size_t go = tb + GRP(1024, 2);
            FOR_BJ { f32x4 g0, g1; unpack8(*(const u32x4*)((const char*)G + go + bj * 256 + vo), g0, g1); f32x4 a = g0 * acc[ai][bj][m][0], b = g1 * acc[ai][bj][m][1];
                if (ADD) { f32x4 m0, m1; unpack8(*(const u32x4*)((const char*)M1 + go + bj * 256 + vo), m0, m1); a += m0; b += m1; }
                *(u32x4*)((char*)O + go + bj * 256 + vo) = pack8(a, b); }
            FENCE_ODD_M; }
    }
};
template <bool BASE_F32> struct EpiResid {
    static constexpr bool PERM = true;
    const float* bf; const bf16_t* bh; bf16_t* O; float* ssq;
    __device__ __forceinline__ void operator()(EPI_ARGS) const {
        const int rt0 = wr * 64 + fr, cl = wc * 32 + 8 * fq; const size_t te = (size_t)u.pm * BM * 1024 + (size_t)u.pn * BM; const unsigned ve = (unsigned)(rt0 * 1024 + cl);
        char* sq = (char*)ssq + ((size_t)u.pm * BM * 16 + u.pn * 4 + wc) * 4; const unsigned vs = (unsigned)rt0 * 64u;
        FOR_AI_M { const size_t ge = te + GRP(1024, 1); float s = 0.f;
            FOR_BJ { f32x4 a, b;
                if (BASE_F32) { const char* p = (const char*)bf + (ge + bj * HALF) * 4 + ve * 4u; a = *(const f32x4*)p; b = *(const f32x4*)(p + 16); } else unpack8(*(const u32x4*)((const char*)bh + (ge + bj * HALF) * 2 + ve * 2u), a, b);
                a += acc[ai][bj][m][0]; b += acc[ai][bj][m][1];
                s += (a[0] * a[0] + a[1] * a[1]) + (a[2] * a[2] + a[3] * a[3]) + (b[0] * b[0] + b[1] * b[1]) + (b[2] * b[2] + b[3] * b[3]);
                *(u32x4*)((char*)O + (ge + bj * HALF) * 2 + ve * 2u) = pack8(a, b); }
            s += __shfl_xor(s, 16); s += __shfl_xor(s, 32);
            if (fq == 0) *(float*)(sq + GRP(16, 4) + vs) = s;
            FENCE_ODD_M; }
    }
};
struct EpiScores {
    static constexpr bool PERM = true;
    const float* ssq; bf16_t* O; LAS float* xch; int tid;
    __device__ __forceinline__ void operator()(EPI_ARGS) const {
        const int rt0 = wr * 64 + fr, cl = wc * 32 + 8 * fq; LAS float* xl = xch + rt0 * 4;
        if (tid < 256) xch[2048 + tid] = rinv16(ssq, (size_t)u.pm * BM + tid);
        asm volatile("s_waitcnt lgkmcnt(0)" ::: "memory"); __builtin_amdgcn_s_barrier(); asm volatile("" ::: "memory");
        FOR_AI_M { const int ro = ai * HALF + m * 16; const float r = xch[2048 + rt0 + ro]; float mx = -3.0e38f;
            FOR_BJ {
#pragma unroll
                for (int n = 0; n < 2; ++n) { acc[ai][bj][m][n] *= r; const f32x4 v = acc[ai][bj][m][n]; mx = fmaxf(fmaxf(mx, fmaxf(v[0], v[1])), fmaxf(v[2], v[3])); } }
            mx = fmaxf(mx, __shfl_xor(mx, 16)); mx = fmaxf(mx, __shfl_xor(mx, 32));
            if (fq == 0) xl[ro * 4 + wc] = mx; }
        asm volatile("s_waitcnt lgkmcnt(0)" ::: "memory"); __builtin_amdgcn_s_barrier(); asm volatile("" ::: "memory");
        FOR_AI_M { const int ro = ai * HALF + m * 16; const f32x4 q = *(const LAS f32x4*)(xl + ro * 4); const float M = fmaxf(fmaxf(q[0], q[1]), fmaxf(q[2], q[3])); float s = 0.f;
            FOR_BJ {
#pragma unroll
                for (int n = 0; n < 2; ++n) { f32x4 v = acc[ai][bj][m][n];
#pragma unroll
                    for (int e = 0; e < 4; ++e) { v[e] = fast_exp2(v[e] - M); s += v[e]; }
                    acc[ai][bj][m][n] = v; } }
            s += __shfl_xor(s, 16); s += __shfl_xor(s, 32);
            if (fq == 0) xl[1024 + ro * 4 + wc] = s; }
        asm volatile("s_waitcnt lgkmcnt(0)" ::: "memory"); __builtin_amdgcn_s_barrier(); asm volatile("" ::: "memory");
        char* ob = (char*)O + ((size_t)u.pm * BM * 1024 + (size_t)u.pn * BM) * 2; const unsigned vo = (unsigned)(rt0 * 1024 + cl) * 2u;
        FOR_AI_M { const int ro = ai * HALF + m * 16; const f32x4 q = *(const LAS f32x4*)(xl + 1024 + ro * 4); const float inv = fast_rcp((q[0] + q[1]) + (q[2] + q[3]));
            char* orow = ob + GRP(1024, 2) + vo;
            FOR_BJ *(u32x4*)(orow + bj * 256) = pack8(acc[ai][bj][m][0] * inv, acc[ai][bj][m][1] * inv); }
    }
};
struct EpiMoe1 {
    static constexpr bool PERM = true;
    const float* ssq; LAS float* xch; int tid;
    __device__ __forceinline__ void operator()(EPI_ARGS) const {
        const int rt0 = wr * 64 + fr, cl = wc * 32 + 8 * fq; const unsigned vo = (unsigned)(rt0 * 512 + cl) * 2u;
        if (tid < 256) xch[2048 + tid] = rinv16(ssq, (size_t)((const GAS int*)u.rows)[tid]);
        asm volatile("s_waitcnt lgkmcnt(0)" ::: "memory"); __builtin_amdgcn_s_barrier(); asm volatile("" ::: "memory");
        FOR_AI_M { const float r = xch[2048 + rt0 + ai * HALF + m * 16];
            f32x4 g0 = acc[ai][0][m][0] * r, g1 = acc[ai][0][m][1] * r; const f32x4 u0 = acc[ai][1][m][0] * r, u1 = acc[ai][1][m][1] * r;
#pragma unroll
            for (int e = 0; e < 4; ++e) { g0[e] = g0[e] * sigm(g0[e]) * u0[e]; g1[e] = g1[e] * sigm(g1[e]) * u1[e]; }
            *(u32x4*)(u.C + GRP(512, 2) + vo) = pack8(g0, g1); }
    }
};
struct EpiMoe2 {
    static constexpr bool PERM = true;
    const float* wbuf;
    __device__ __forceinline__ void operator()(EPI_ARGS) const {
        const int rt0 = wr * 64 + fr, cl = wc * 32 + 8 * fq; const unsigned vo = (unsigned)(rt0 * 1024 + cl) * 2u; const char* wb = (const char*)(wbuf + (size_t)u.pm * BM); const unsigned vw = (unsigned)rt0 * 4u;
        FOR_AI_M { const float w = *(const float*)(wb + GRP(1, 4) + vw); char* orow = u.C + GRP(1024, 2) + vo;
            FOR_BJ *(u32x4*)(orow + bj * 256) = pack8(acc[ai][bj][m][0] * w, acc[ai][bj][m][1] * w); }
    }
};

struct SchedFlat {
    const char* A; const char* B; char* C; size_t a_tile, b_tile, b_z, c_row, c_col; int nM, nN, pm_per_z, G, c;
    __device__ __forceinline__ bool next(int i, Unit& u) const {
        const long L = (long)i * G + c; if (L >= (long)nM * nN) return false;
        int pm, pn; tile_of((int)L, nM, nN, pm, pn); u.pm = pm; u.pn = pn; u.z = pm / pm_per_z; u.pad = 0;
        u.A = A + (size_t)pm * a_tile; u.B = B + (size_t)u.z * b_z + (size_t)pn * b_tile; u.C = C + (size_t)pm * c_row + (size_t)pn * c_col; u.rows = nullptr; return true; }
};
struct SchedWqk {
    const char* KVX; const char* WQS; char* WQK; int nz, G, c;
    __device__ __forceinline__ bool next(int i, Unit& u) const {
        const int L = i * G + c; if (L >= nz * 4) return false;
        const int z = L >> 2, pn = L & 3, b = z >> 2, h = z & 3; u.pm = 0; u.pn = pn; u.z = z; u.pad = 0; u.rows = nullptr;
        u.A = KVX + ((size_t)b * 256 * 2048 + h * 256) * 2; u.B = WQS + ((size_t)pn * 256 * 1024 + h * 256) * 2; u.C = WQK + ((size_t)b * 1048576 + (size_t)h * 256 * 1024 + pn * 256) * 2; return true; }
};
struct SchedVwo {
    const char* WOT; const char* KVX; char* VWO; int nz, G, c;
    __device__ __forceinline__ bool next(int i, Unit& u) const {
        const int L = i * G + c; if (L >= nz * 4) return false;
        const int z = L >> 2, pm = L & 3, b = z >> 2, h = z & 3; u.pm = pm; u.pn = 0; u.z = z; u.pad = 0; u.rows = nullptr;
        u.A = WOT + ((size_t)pm * 256 * 1024 + h * 256) * 2; u.B = KVX + ((size_t)b * 256 * 2048 + 1024 + h * 256) * 2; u.C = VWO + ((size_t)b * 1048576 + (size_t)pm * 256 * 1024 + h * 256) * 2; return true; }
};
struct SchedMoe {
    const char* A; const char* Bw; char* C; const int* rowtok; const int* tile_e; const int* ntiles; size_t a_row  , b_e, b_tile, c_row, c_col; int G, cv;
    __device__ __forceinline__ bool next(int i, Unit& u) const {
        const int L = i * G + cv, rt = L >> 2, pn = L & 3;
        const int nt = __builtin_amdgcn_readfirstlane(__hip_atomic_load(ntiles, __ATOMIC_RELAXED, __HIP_MEMORY_SCOPE_AGENT)); if (rt >= nt) return false;
        const int e = __builtin_amdgcn_readfirstlane(__hip_atomic_load(tile_e + rt, __ATOMIC_RELAXED, __HIP_MEMORY_SCOPE_AGENT));
        u.pm = rt; u.pn = pn; u.z = e; u.pad = 0; u.rows = rowtok + (size_t)rt * 256;
        u.A = A + (size_t)rt * 256 * a_row; u.B = Bw + (size_t)e * b_e + (size_t)pn * b_tile; u.C = C + (size_t)rt * 256 * c_row + (size_t)pn * c_col; return true; }
};
struct Params {
    const float* in[27]; float* out; unsigned* ctl;
    bf16_t *WIN_T, *WKV_T, *WA_T, *WB_T, *WOUT_T, *WQS, *WO_T, *WR_T, *WGU_T, *WD_T, *WSP;
    bf16_t *XN, *MN, *KVX, *Q, *K, *V, *ZU, *ZV, *GA, *GB, *OG, *YA, *YB, *M1, *MERGED, *H1, *PX, *H2, *WQK, *VWO, *HB, *YBX;
    float *ROPE, *LSE, *SSQ1, *SSQ2, *WGT, *WBUF;
    int *EID, *BCNT, *TOT, *ROWTOK, *POSOF, *TILE_E;
    int nb, T, b0, ph_lo, ph_hi, pad;
};
struct Ctx { LAS unsigned char* lds; int tid, lane, wave, vcu, G, gw, ngw; };
#define LDS_WAIT() asm volatile("s_waitcnt lgkmcnt(0)" ::: "memory")
#define VM_WAIT() asm volatile("s_waitcnt vmcnt(0)" ::: "memory")
__device__ __forceinline__ float wave_sum(float v) {
#pragma unroll
    for (int o = 1; o < 64; o <<= 1) v += __shfl_xor(v, o);
    return v;
}
typedef short v4i16_t __attribute__((ext_vector_type(4)));
__device__ __forceinline__ s16x4 tr_read(LAS unsigned char* p) { return __builtin_bit_cast(s16x4, __builtin_amdgcn_ds_read_tr16_b64_v4i16((LAS v4i16_t*)p)); }

__device__ __forceinline__ int rowmap(int mode, int n) {
    if (mode == 1) { if (n < 1536) { const int d = n & 63; return (n & ~63) + 2 * (d & 31) + (d >> 5); } return n; }
    if (mode == 2) return (n >> 7) * 256 + (n & 127);
    if (mode == 3) return (n >> 7) * 256 + 128 + (n & 127);
    return n;
}
__device__ __forceinline__ void tr_item(const float* W, int ldw, int K, bf16_t* WT, const float* kscale, int mode, LAS float* scr, int kb, int nbk, int lane) {
    const int k0 = 64 * kb, n0 = 32 * nbk;
#pragma unroll 8
    for (int i = 0; i < 32; ++i) { const int kk = 2 * i + (lane >> 5); float v = W[(size_t)(k0 + kk) * ldw + n0 + (lane & 31)]; if (kscale) v *= kscale[k0 + kk]; scr[kk * 33 + (lane & 31)] = v; }
    LDS_WAIT(); asm volatile("" ::: "memory");
    const int c = lane & 7;
#pragma unroll
    for (int j = 0; j < 4; ++j) { const int n = (lane >> 3) + 8 * j; const LAS float* s = scr + (8 * c) * 33 + n;
        u32x4 o; o.x = cvt_pk_bf16(s[0 * 33], s[1 * 33]); o.y = cvt_pk_bf16(s[2 * 33], s[3 * 33]); o.z = cvt_pk_bf16(s[4 * 33], s[5 * 33]); o.w = cvt_pk_bf16(s[6 * 33], s[7 * 33]);
        *(u32x4*)(WT + (size_t)rowmap(mode, n0 + n) * K + k0 + 8 * c) = o; }
    LDS_WAIT(); asm volatile("" ::: "memory");
}
__device__ __forceinline__ void rms_row_bf16(const float* xrow, const float* g, bf16_t* orow, int lane) {
    const f32x4* xr = (const f32x4*)xrow + lane; const f32x4* gr = (const f32x4*)g + lane;
    f32x4 v[4]; float s = 0.f;
#pragma unroll
    for (int j = 0; j < 4; ++j) { v[j] = xr[64 * j]; s += (v[j][0] * v[j][0] + v[j][1] * v[j][1]) + (v[j][2] * v[j][2] + v[j][3] * v[j][3]); }
    const float r = rsqrtf(wave_sum(s) * (1.0f / 1024.0f) + 1e-6f);
    u32x2* o8 = (u32x2*)orow + lane;
#pragma unroll
    for (int j = 0; j < 4; ++j) { const f32x4 gg = gr[64 * j]; u32x2 w; w.x = cvt_pk_bf16(v[j][0] * r * gg[0], v[j][1] * r * gg[1]); w.y = cvt_pk_bf16(v[j][2] * r * gg[2], v[j][3] * r * gg[3]); o8[64 * j] = w; }
}
__device__ __forceinline__ void p0_prologue(const Params& P, const Ctx& X) {
    LAS float* scr = (LAS float*)(X.lds + X.wave * 16384);
    const float *w_in = P.in[4], *w_oa = P.in[10], *w_ob = P.in[11], *w_out = P.in[12], *xg = P.in[13], *w_q = P.in[15], *w_kv = P.in[16], *w_o = P.in[17], *moe_g = P.in[18],
                *w_rg = P.in[19], *w_re = P.in[21], *w_ge = P.in[23], *w_ue = P.in[24], *w_de = P.in[25], *w_sp = P.in[6];
    constexpr int I_IN = 16 * 168, I_KV = 16 * 64, I_A = 4 * 32, I_B = 8 * 32, I_OUT = 16 * 32, I_O = 16 * 32, I_G = 16 * 16 * 32, I_U = I_G, I_D = 8 * 32 * 32;
    constexpr int NITEMS = I_IN + I_KV + I_A + I_B + I_OUT + I_O + I_G + I_U + I_D;
    for (int it = X.gw; it < NITEMS; it += X.ngw) {
        int r = it;
        if (r < I_IN) { tr_item(w_in, 5376, 1024, P.WIN_T, nullptr, 1, scr, r / 168, r % 168, X.lane); continue; } r -= I_IN;
        if (r < I_KV) { tr_item(w_kv, 2048, 1024, P.WKV_T, nullptr, 0, scr, r / 64, r % 64, X.lane); continue; } r -= I_KV;
        if (r < I_A) { tr_item(w_oa, 1024, 256, P.WA_T, nullptr, 0, scr, r / 32, r % 32, X.lane); continue; } r -= I_A;
        if (r < I_B) { tr_item(w_ob, 1024, 512, P.WB_T, nullptr, 0, scr, r / 32, r % 32, X.lane); continue; } r -= I_B;
        if (r < I_OUT) { tr_item(w_out, 1024, 1024, P.WOUT_T, nullptr, 0, scr, r / 32, r % 32, X.lane); continue; } r -= I_OUT;
        if (r < I_O) { tr_item(w_o, 1024, 1024, P.WO_T, nullptr, 0, scr, r / 32, r % 32, X.lane); continue; } r -= I_O;
        if (r < I_G) { const int e = r >> 8, q = r & 255; tr_item(w_ge + (size_t)e * 524288, 512, 1024, P.WGU_T + (size_t)e * 1048576, moe_g, 2, scr, q >> 4, q & 15, X.lane); continue; } r -= I_G;
        if (r < I_U) { const int e = r >> 8, q = r & 255; tr_item(w_ue + (size_t)e * 524288, 512, 1024, P.WGU_T + (size_t)e * 1048576, moe_g, 3, scr, q >> 4, q & 15, X.lane); continue; } r -= I_U;
        { const int e = r >> 8, q = r & 255; tr_item(w_de + (size_t)e * 524288, 1024, 512, P.WD_T + (size_t)e * 524288, nullptr, 0, scr, q >> 5, q & 31, X.lane); }
    }
    const int gt = X.gw * 64 + X.lane, ngt = X.ngw * 64;
    for (int i = gt; i < 1024 * 128; i += ngt) { const int row = i >> 7; const float g = xg[row]; const f32x4 a = *(const f32x4*)(w_q + (size_t)i * 8) * g, b = *(const f32x4*)(w_q + (size_t)i * 8 + 4) * g; *(u32x4*)(P.WQS + (size_t)i * 8) = pack8(a, b); }
    for (int i = gt; i < 48 * 1024; i += ngt) { const int row = i >> 10, k = i & 1023; float v = 0.f; if (row < 4) v = w_rg[k * 4 + row]; else if (row < 36) v = w_re[k * 32 + row - 4];
        P.WR_T[i] = (bf16_t)(cvt_pk_bf16(v * moe_g[k], 0.f) & 0xffffu); }
    for (int i = gt; i < 4 * 128 * 128; i += ngt) { const int s = i & 127, t = (i >> 7) & 127; P.WSP[i] = (bf16_t)(cvt_pk_bf16(s <= t ? w_sp[i] : 0.f, 0.f) & 0xffffu); }
    { const int* pos = (const int*)P.in[2] + (size_t)P.b0 * 4096;
      for (int i = gt; i < P.T * 32; i += ngt) { const int t = i >> 5, f = i & 31; const float ang = (float)pos[t] * powf(10000.0f, -(float)f / 32.0f); P.ROPE[(size_t)t * 64 + f] = cosf(ang); P.ROPE[(size_t)t * 64 + 32 + f] = sinf(ang); } }
    { const float* x = P.in[0] + (size_t)P.b0 * 4096 * 1024; const float* mem = P.in[1] + (size_t)P.b0 * 256 * 1024;
      for (int m = X.gw; m < P.T; m += X.ngw) rms_row_bf16(x + (size_t)m * 1024, P.in[3], P.XN + (size_t)m * 1024, X.lane);
      for (int m = X.gw; m < P.nb * 256; m += X.ngw) rms_row_bf16(mem + (size_t)m * 1024, P.in[14], P.MN + (size_t)m * 1024, X.lane); }
}

__device__ __forceinline__ void attn_phase(const Params& P, const Ctx& X) {
    LAS unsigned char* Ks = X.lds; LAS unsigned char* Vs = X.lds + 32768;
    const int lane = X.lane, w = X.wave, fr = lane & 15, fq = lane >> 4;
    const int nunits = P.nb * 384;
    const int srow = X.tid >> 3, sch = X.tid & 7;
    const unsigned ldsk = (unsigned)(srow * 128 + ((sch ^ ((srow >> 1) & 7)) << 4)), ldsv = (unsigned)(srow * 128 + ((sch ^ (srow & 7)) << 4));
    for (int U = X.vcu; U < nunits; U += X.G) {
        const int b = U / 384, rem = U - b * 384, head = rem >> 5, blk = rem & 31, g = head >> 2, j = head & 3;
        const int dsh = 2 * g, dil = 1 << dsh, nbk = 32 >> dsh, r = blk / nbk, n = blk - r * nbk;
        const long ebase = ((long)b * 4096 + (long)(n - 1) * 128 * dil + r) * 768 + head * 64;
        const unsigned vsrc = (unsigned)(srow * dil * 768 + sch * 8) * 2u; const size_t pstride = (size_t)64 * dil * 768 * 2;
        const char* kb = (const char*)P.K + ebase * 2; const char* vb = (const char*)P.V + ebase * 2;
        u32x4 kreg[4], vreg[4];
#pragma unroll
        for (int p = 0; p < 4; ++p) {
            if (p >= 2 || n > 0) { kreg[p] = *(const u32x4*)(kb + p * pstride + vsrc); vreg[p] = *(const u32x4*)(vb + p * pstride + vsrc); }
            else { kreg[p] = (u32x4){0u, 0u, 0u, 0u}; vreg[p] = (u32x4){0u, 0u, 0u, 0u}; } }
        const unsigned vq = (unsigned)((128 + 16 * w + fr) * dil * 768 + 8 * fq) * 2u;
        const bf16x8 q0 = *(const bf16x8*)((const char*)P.Q + ebase * 2 + vq), q1 = *(const bf16x8*)((const char*)P.Q + ebase * 2 + 64 + vq);
        __syncthreads();
#pragma unroll
        for (int p = 0; p < 4; ++p) { *(LAS u32x4*)(Ks + p * 8192 + ldsk) = kreg[p]; *(LAS u32x4*)(Vs + p * 8192 + ldsv) = vreg[p]; }
        __syncthreads();
        const int s0 = w < 6 ? w : 6;
        f32x4 sc[10];
        { const int row0 = 16 * s0 + fr; const int sw = (row0 >> 1) & 7;
          LAS unsigned char* kp0 = Ks + row0 * 128 + ((fq ^ sw) << 4); LAS unsigned char* kp1 = Ks + row0 * 128 + (((4 + fq) ^ sw) << 4);
#pragma unroll
          for (int st = 0; st < 10; ++st) { const bf16x8 k0 = *(const LAS bf16x8*)(kp0 + st * 2048), k1 = *(const LAS bf16x8*)(kp1 + st * 2048);
            f32x4 a = {0.f, 0.f, 0.f, 0.f}; a = __builtin_amdgcn_mfma_f32_16x16x32_bf16(k0, q0, a, 0, 0, 0); a = __builtin_amdgcn_mfma_f32_16x16x32_bf16(k1, q1, a, 0, 0, 0); sc[st] = a; } }
        const int qi = 16 * w + fr, kc0 = 16 * s0 + 4 * fq - qi, klo = n > 0 ? 0 : 128 - qi; float mx = -3.0e38f;
#pragma unroll
        for (int st = 0; st < 10; ++st)
#pragma unroll
            for (int e = 0; e < 4; ++e) { const int dk = kc0 + 16 * st + e; const bool ok = (dk >= 0) && (dk <= 128) && (dk >= klo); sc[st][e] = ok ? sc[st][e] : -3.0e38f; mx = fmaxf(mx, sc[st][e]); }
        mx = fmaxf(mx, __shfl_xor(mx, 16)); mx = fmaxf(mx, __shfl_xor(mx, 32));
        float l = 0.f;
#pragma unroll
        for (int st = 0; st < 10; ++st)
#pragma unroll
            for (int e = 0; e < 4; ++e) { const float pe = sc[st][e] > -1.0e38f ? fast_exp2(sc[st][e] - mx) : 0.f; sc[st][e] = pe; l += pe; }
        l += __shfl_xor(l, 16); l += __shfl_xor(l, 32);
        f32x4 o[4];
#pragma unroll
        for (int dt = 0; dt < 4; ++dt) o[dt] = (f32x4){0.f, 0.f, 0.f, 0.f};
        { const int krow = 16 * s0 + 4 * fq + (fr >> 2), ksw = krow & 7;
          const int by = (fr & 1) * 8, chl = (fr & 3) >> 1;
#pragma unroll
          for (int kk = 0; kk < 5; ++kk) {
            bf16x8 pb; { const unsigned w0 = cvt_pk_bf16(sc[2 * kk][0], sc[2 * kk][1]), w1 = cvt_pk_bf16(sc[2 * kk][2], sc[2 * kk][3]), w2 = cvt_pk_bf16(sc[2 * kk + 1][0], sc[2 * kk + 1][1]), w3 = cvt_pk_bf16(sc[2 * kk + 1][2], sc[2 * kk + 1][3]);
                pb = __builtin_bit_cast(bf16x8, (u32x4){w0, w1, w2, w3}); }
#pragma unroll
            for (int dt = 0; dt < 4; ++dt) { LAS unsigned char* vp = Vs + krow * 128 + (((2 * dt + chl) ^ ksw) << 4) + by + kk * 4096;
                const s16x4 lo = tr_read(vp), hi = tr_read(vp + 2048);
                const bf16x8 va = {lo[0], lo[1], lo[2], lo[3], hi[0], hi[1], hi[2], hi[3]};
                o[dt] = __builtin_amdgcn_mfma_f32_16x16x32_bf16(va, pb, o[dt], 0, 0, 0); }
          } }
        const float inv = fast_rcp(l); const long qtok = (long)b * 4096 + ((long)n * 128 + 16 * w + fr) * dil + r;
        bf16_t* og = P.OG + ((size_t)g * P.T + qtok) * 256 + j * 64 + 4 * fq;
#pragma unroll
        for (int dt = 0; dt < 4; ++dt) { u32x2 wv; wv.x = cvt_pk_bf16(o[dt][0] * inv, o[dt][1] * inv); wv.y = cvt_pk_bf16(o[dt][2] * inv, o[dt][3] * inv); *(u32x2*)(og + 16 * dt) = wv; }
        if (fq == 0) P.LSE[((size_t)g * P.T + qtok) * 4 + j] = mx + __builtin_amdgcn_logf(l);
    }
    __syncthreads();
}
__device__ __forceinline__ void merge_phase(const Params& P, const Ctx& X) {
    const int gt = X.gw * 64 + X.lane, ngt = X.ngw * 64; const size_t T = (size_t)P.T;
    for (int i = gt; i < P.T * 32; i += ngt) { const size_t t = (size_t)(i >> 5); const int c8 = i & 31, j = c8 >> 3;
        const float l0 = P.LSE[t * 4 + j], l1 = P.LSE[(T + t) * 4 + j], l2 = P.LSE[(2 * T + t) * 4 + j]; const float M = fmaxf(l0, fmaxf(l1, l2));
        const float e0 = fast_exp2(l0 - M), e1 = fast_exp2(l1 - M), e2 = fast_exp2(l2 - M), inv = fast_rcp(e0 + e1 + e2);
        f32x4 a0, b0, a1, b1, a2, b2; unpack8(*(const u32x4*)(P.OG + t * 256 + c8 * 8), a0, b0); unpack8(*(const u32x4*)(P.OG + (T + t) * 256 + c8 * 8), a1, b1); unpack8(*(const u32x4*)(P.OG + (2 * T + t) * 256 + c8 * 8), a2, b2);
        *(u32x4*)(P.YA + t * 256 + c8 * 8) = pack8((a0 * e0 + a1 * e1 + a2 * e2) * inv, (b0 * e0 + b1 * e1 + b2 * e2) * inv); }
}
__device__ __forceinline__ int gsw(int row) { return ((row & 3) | (((row >> 3) & 1) << 2)) << 1; }
__device__ __forceinline__ void gmlp_phase(const Params& P, const Ctx& X) {
    LAS unsigned char* VL = X.lds; const int lane = X.lane, w = X.wave, fr = lane & 15, fq = lane >> 4;
    const float* vg = P.in[8]; const float* vb = P.in[9]; const float* bsp = P.in[7];
    const int nch = P.T / 128;
    for (int ch = X.vcu; ch < nch; ch += X.G) {
        const size_t t0 = (size_t)ch * 128;
        __syncthreads();
        { const f32x4 g0 = *(const f32x4*)(vg + 8 * lane), g1 = *(const f32x4*)(vg + 8 * lane + 4), b0 = *(const f32x4*)(vb + 8 * lane), b1 = *(const f32x4*)(vb + 8 * lane + 4);
          const char* zb = (const char*)(P.ZV + (t0 + 16 * w) * 512) + 16 * lane;
#pragma unroll 4
          for (int i = 0; i < 16; ++i) { const int s = 16 * w + i; f32x4 a, b; unpack8(*(const u32x4*)(zb + i * 1024), a, b);
            const float mean = wave_sum((a[0] + a[1]) + (a[2] + a[3]) + (b[0] + b[1]) + (b[2] + b[3])) * (1.0f / 512.0f); a -= mean; b -= mean;
            const float rstd = rsqrtf(wave_sum((a[0] * a[0] + a[1] * a[1]) + (a[2] * a[2] + a[3] * a[3]) + (b[0] * b[0] + b[1] * b[1]) + (b[2] * b[2] + b[3] * b[3])) * (1.0f / 512.0f) + 1e-5f);
            *(LAS u32x4*)(VL + s * 1024 + ((lane ^ gsw(s)) << 4)) = pack8(a * rstd * g0 + b0, b * rstd * g1 + b1); } }
        __syncthreads();
        const int gch = w >> 1; const char* wsp = (const char*)(P.WSP + (size_t)gch * 16384) + (unsigned)(fr * 128 + 8 * fq) * 2u;
        const int by = (fr & 1) * 8, chl = (fr & 3) >> 1, sr0 = 8 * fq + (fr >> 2);
        const char* zu = (const char*)(P.ZU + t0 * 512); char* yb = (char*)(P.YB + t0 * 512); const unsigned vo = (unsigned)(fr * 512 + 64 * w + 4 * fq) * 2u; const float* bsg = bsp + gch * 128 + fr;
#pragma unroll
        for (int th = 0; th < 2; ++th) {
            f32x4 acc[4][4];
#pragma unroll
            for (int ct = 0; ct < 4; ++ct)
#pragma unroll
                for (int tq = 0; tq < 4; ++tq) acc[ct][tq] = (f32x4){0.f, 0.f, 0.f, 0.f};
#pragma unroll
            for (int ks = 0; ks < 4; ++ks) { if (32 * ks > 64 * th + 63) continue;
                const int srow = 32 * ks + sr0;
                bf16x8 va[4];
#pragma unroll
                for (int ct = 0; ct < 4; ++ct) { const int chn = 8 * w + 2 * ct + chl;
                    const s16x4 lo = tr_read(VL + srow * 1024 + ((chn ^ gsw(srow)) << 4) + by), hi = tr_read(VL + (srow + 4) * 1024 + ((chn ^ gsw(srow + 4)) << 4) + by);
                    va[ct] = (bf16x8){lo[0], lo[1], lo[2], lo[3], hi[0], hi[1], hi[2], hi[3]}; }
#pragma unroll
                for (int tq = 0; tq < 4; ++tq) { const int tt = 4 * th + tq; if (32 * ks > 16 * tt + 15) continue;
                    const bf16x8 wb = *(const bf16x8*)(wsp + tt * 4096 + ks * 64);
#pragma unroll
                    for (int ct = 0; ct < 4; ++ct) acc[ct][tq] = __builtin_amdgcn_mfma_f32_16x16x32_bf16(va[ct], wb, acc[ct][tq], 0, 0, 0); }
            }
#pragma unroll
            for (int tq = 0; tq < 4; ++tq) { const int tt = 4 * th + tq; const float bs = bsg[16 * tt];
#pragma unroll
                for (int ct = 0; ct < 4; ++ct) { const size_t off = (size_t)tt * 16384 + ct * 32; const u32x2 uu = *(const u32x2*)(zu + off + vo); const f32x4 a = acc[ct][tq] + bs;
                    u32x2 o; o.x = cvt_pk_bf16(bf_lo(uu.x) * a[0], bf_hi(uu.x) * a[1]); o.y = cvt_pk_bf16(bf_lo(uu.y) * a[2], bf_hi(uu.y) * a[3]); *(u32x2*)(yb + off + vo) = o; } }
        }
    }
    __syncthreads();
}
__device__ __forceinline__ void router_phase(const Params& P, const Ctx& X) {
    LAS unsigned char* WR = X.lds; LAS float* LG = (LAS float*)(X.lds + 98304) + X.wave * 1536; LAS int* CNT = (LAS int*)(X.lds + 98304 + 49152);
    const int lane = X.lane, w = X.wave, fr = lane & 15, fq = lane >> 4;
    for (int i = X.tid; i < 48 * 128; i += 512) { const int row = i >> 7, chk = i & 127; *(LAS u32x4*)(WR + row * 2048 + ((chk ^ (row & 15)) << 4)) = *(const u32x4*)(P.WR_T + (size_t)i * 8); }
    const float* bg = P.in[20]; const float* be = P.in[22];
    const int ntb = P.T / 256;
    for (int tbk = X.vcu; tbk < ntb; tbk += X.G) {
        if (X.tid < 32) CNT[X.tid] = 0;
        __syncthreads();
        f32x4 acc[2][3];
#pragma unroll
        for (int a = 0; a < 2; ++a)
#pragma unroll
            for (int c = 0; c < 3; ++c) acc[a][c] = (f32x4){0.f, 0.f, 0.f, 0.f};
        const bf16_t* hrow = P.H2 + ((size_t)tbk * 256 + 32 * w + fr) * 1024 + 8 * fq;
#pragma unroll 4
        for (int ks = 0; ks < 32; ++ks) {
            const bf16x8 a0 = *(const bf16x8*)(hrow + 32 * ks), a1 = *(const bf16x8*)(hrow + 16 * 1024 + 32 * ks);
#pragma unroll
            for (int c = 0; c < 3; ++c) { const int row = 16 * c + fr; const bf16x8 bw = *(const LAS bf16x8*)(WR + row * 2048 + (((4 * ks + fq) ^ (row & 15)) << 4));
                acc[0][c] = __builtin_amdgcn_mfma_f32_16x16x32_bf16(a0, bw, acc[0][c], 0, 0, 0); acc[1][c] = __builtin_amdgcn_mfma_f32_16x16x32_bf16(a1, bw, acc[1][c], 0, 0, 0); }
        }
#pragma unroll
        for (int a = 0; a < 2; ++a)
#pragma unroll
            for (int c = 0; c < 3; ++c)
#pragma unroll
                for (int e = 0; e < 4; ++e) LG[(16 * a + 4 * fq + e) * 48 + 16 * c + fr] = acc[a][c][e];
        LDS_WAIT(); asm volatile("" ::: "memory");
        if (lane < 32) {
            const int t = tbk * 256 + 32 * w + lane; const float r = rinv16(P.SSQ2, (size_t)t); const LAS float* lg = LG + lane * 48;
            float g4[4]; int grp = 0; float gm = -3.0e38f;
#pragma unroll
            for (int c = 0; c < 4; ++c) { g4[c] = lg[c] * r + bg[c]; if (g4[c] > gm) { gm = g4[c]; grp = c; } }
            float den = 0.f;
#pragma unroll
            for (int c = 0; c < 4; ++c) den += __expf(g4[c] - gm);
            float v0 = -3.0e38f, v1 = -3.0e38f; int i0 = 0, i1 = 0;
#pragma unroll
            for (int i = 0; i < 8; ++i) { const float v = lg[4 + grp * 8 + i] * r + be[grp * 8 + i]; if (v > v0) { v1 = v0; i1 = i0; v0 = v; i0 = i; } else if (v > v1) { v1 = v; i1 = i; } }
            const float e1 = __expf(v1 - v0), gg = 1.0f / den, p0 = gg / (1.0f + e1), p1 = gg * e1 / (1.0f + e1);
            P.EID[2 * t] = grp * 8 + i0; P.EID[2 * t + 1] = grp * 8 + i1; P.WGT[2 * t] = p0; P.WGT[2 * t + 1] = p1;
            __hip_atomic_fetch_add(&CNT[grp * 8 + i0], 1, __ATOMIC_RELAXED, __HIP_MEMORY_SCOPE_WORKGROUP); __hip_atomic_fetch_add(&CNT[grp * 8 + i1], 1, __ATOMIC_RELAXED, __HIP_MEMORY_SCOPE_WORKGROUP);
        }
        __syncthreads();
        if (X.tid < 32) P.BCNT[tbk * 32 + X.tid] = CNT[X.tid];
        __syncthreads();
    }
}
__device__ __forceinline__ void positions_phase(const Params& P, const Ctx& X) {
    LAS int* TOT = (LAS int*)X.lds; LAS int* BEF = TOT + 32; LAS int* PST = TOT + 64; LAS int* EL = TOT + 128;
    const int ntb = P.T / 256;
    for (int tbk = X.vcu; tbk < ntb; tbk += X.G) {
        __syncthreads();
        if (X.tid < 32) { int tot = 0, bef = 0; for (int q = 0; q < ntb; ++q) { const int c = P.BCNT[q * 32 + X.tid]; tot += c; if (q < tbk) bef += c; } TOT[X.tid] = tot; BEF[X.tid] = bef; }
        EL[X.tid] = P.EID[(size_t)tbk * 512 + X.tid];
        __syncthreads();
        if (X.tid == 0) { int s = 0; for (int e = 0; e < 32; ++e) { PST[e] = s; s += (TOT[e] + 255) & ~255; } PST[32] = s; }
        __syncthreads();
        { const int a = X.tid, e = EL[a]; int rank = 0; for (int q = 0; q < a; ++q) rank += (EL[q] == e) ? 1 : 0;
          const int pos = PST[e] + BEF[e] + rank; const size_t ga = (size_t)tbk * 512 + a;
          P.ROWTOK[pos] = (int)(ga >> 1); P.WBUF[pos] = P.WGT[ga]; P.POSOF[ga] = pos; }
        if (tbk == 0) { for (int e = 0; e < 32; ++e) for (int q = PST[e] + TOT[e] + X.tid; q < PST[e + 1]; q += 512) { P.ROWTOK[q] = 0; P.WBUF[q] = 0.f; } }
        if (tbk == 0) { const int nt = PST[32] >> 8; for (int rt = X.tid; rt < nt; rt += 512) { int e = 0; while (PST[e + 1] <= rt * 256) ++e; P.TILE_E[rt] = e; } if (X.tid == 0) P.TILE_E[1024] = nt; }
    }
    __syncthreads();
}
__device__ __forceinline__ void final_phase(const Params& P, const Ctx& X) {
    const float* g = P.in[26]; const int lane = X.lane;
    for (int t = X.gw; t < P.T; t += X.ngw) {
        const int p0 = P.POSOF[2 * (size_t)t], p1 = P.POSOF[2 * (size_t)t + 1];
        const bf16_t* h = P.H2 + (size_t)t * 1024; const bf16_t* y0 = P.YBX + (size_t)p0 * 1024; const bf16_t* y1 = P.YBX + (size_t)p1 * 1024;
        f32x4 v[4]; float s = 0.f;
#pragma unroll
        for (int q = 0; q < 2; ++q) { f32x4 a, b, c, d, e, f; unpack8(*(const u32x4*)(h + 512 * q + 8 * lane), a, b); unpack8(*(const u32x4*)(y0 + 512 * q + 8 * lane), c, d); unpack8(*(const u32x4*)(y1 + 512 * q + 8 * lane), e, f);
            v[2 * q] = a + c + e; v[2 * q + 1] = b + d + f; }
#pragma unroll
        for (int q = 0; q < 4; ++q) s += (v[q][0] * v[q][0] + v[q][1] * v[q][1]) + (v[q][2] * v[q][2] + v[q][3] * v[q][3]);
        const float r = rsqrtf(wave_sum(s) * (1.0f / 1024.0f) + 1e-6f);
        float* o = P.out + (size_t)t * 1024;
#pragma unroll
        for (int q = 0; q < 2; ++q) { const f32x4 ga = *(const f32x4*)(g + 512 * q + 8 * lane), gb = *(const f32x4*)(g + 512 * q + 8 * lane + 4);
            *(f32x4*)(o + 512 * q + 8 * lane) = v[2 * q] * r * ga; *(f32x4*)(o + 512 * q + 8 * lane + 4) = v[2 * q + 1] * r * gb; }
    }
}
#define XB_TMO      128
#define XB_XCNT(j)  (256  + 64 * (j))
#define XB_XSUB(j)  (1280 + 64 * (j))
#define XB_XGEN(j)  (2304 + 64 * (j))
#define XB_TOP      3328
#define XB_TOPGEN   3392
#define XCD_BAR_WORDS 3456
#define XB_SPIN_CAP (1u << 22)
__device__ __forceinline__ unsigned xb_ld(unsigned* p)              { return __hip_atomic_load(p, __ATOMIC_RELAXED, __HIP_MEMORY_SCOPE_AGENT); }
__device__ __forceinline__ unsigned xb_add(unsigned* p, unsigned v) { return __hip_atomic_fetch_add(p, v, __ATOMIC_RELAXED, __HIP_MEMORY_SCOPE_AGENT); }
__device__ __forceinline__ unsigned xb_xcc_id() { return (unsigned)__builtin_amdgcn_s_getreg((3 << 11) | 20) & 0xFu; }
#define XB_SPIN(cond, bar) do { unsigned _sp = 0; while (cond) { __builtin_amdgcn_s_sleep(1); \
    if ((++_sp & 255u) == 0u) { if (xb_ld(&(bar)[XB_TMO])) break; if (_sp > XB_SPIN_CAP) { atomicAdd(&(bar)[XB_TMO], 1u); break; } } } } while (0)
struct XcdBarrier { unsigned* bar; unsigned x; volatile LAS unsigned* st; };
__device__ __forceinline__ XcdBarrier xcd_barrier_post(unsigned* bar, volatile LAS unsigned* st) {
    XcdBarrier b; b.bar = bar; b.x = xb_xcc_id(); b.st = st;
    if (threadIdx.x == 0) (void)xb_add(&bar[XB_XCNT(b.x)], 1u);
    return b;
}
__device__ __forceinline__ void xcd_barrier_complete(unsigned* bar, unsigned x, unsigned& nloc, unsigned& nx) {
    const unsigned G = gridDim.x * gridDim.y * gridDim.z;
    unsigned sum, cnt, mine, sp = 0u;
    for (;;) {
        sum = 0u; cnt = 0u; mine = 0u;
#pragma unroll
        for (unsigned j = 0; j < 16; ++j) { const unsigned c = xb_ld(&bar[XB_XCNT(j)]); sum += c; cnt += (c > 0u) ? 1u : 0u; mine = (j == x) ? c : mine; }
        if (sum == G) break;
        __builtin_amdgcn_s_sleep(1);
        if ((++sp & 255u) == 0u) { if (xb_ld(&bar[XB_TMO])) break; if (sp > XB_SPIN_CAP) { atomicAdd(&bar[XB_TMO], 1u); break; } }
    }
    nloc = mine > 0u ? mine : 1u; nx = cnt > 0u ? cnt : 1u;
}
__device__ __forceinline__ void xcd_barrier(const XcdBarrier& b) {
    asm volatile("s_waitcnt vmcnt(0)" ::: "memory");
    __syncthreads();
    if (threadIdx.x == 0) {
        unsigned* bar = b.bar;
        __builtin_amdgcn_s_waitcnt(0);
        unsigned nloc = b.st[0], nx = b.st[1];
        if (nloc == 0u) { xcd_barrier_complete(bar, b.x, nloc, nx); b.st[0] = nloc; b.st[1] = nx; }
        const unsigned old = xb_add(&bar[XB_XSUB(b.x)], 1u);
        const unsigned gen = old / nloc;
        if (old + 1u == (gen + 1u) * nloc) {
            __builtin_amdgcn_fence(__ATOMIC_RELEASE, "agent");
            asm volatile("s_waitcnt vmcnt(0)" ::: "memory");
            const unsigned og = xb_add(&bar[XB_TOP], 1u);
            const unsigned tg = og / nx;
            if (og + 1u == (tg + 1u) * nx) xb_add(&bar[XB_TOPGEN], 1u);
            else XB_SPIN(xb_ld(&bar[XB_TOPGEN]) == tg, bar);
            __builtin_amdgcn_fence(__ATOMIC_ACQUIRE, "agent");
            xb_add(&bar[XB_XGEN(b.x)], 1u);
            asm volatile("s_waitcnt vmcnt(0)" ::: "memory");
        } else {
            XB_SPIN(xb_ld(&bar[XB_XGEN(b.x)]) == gen, bar);
            __builtin_amdgcn_fence(__ATOMIC_ACQUIRE, "agent");
            asm volatile("s_waitcnt vmcnt(0)" ::: "memory");
        }
    }
    __syncthreads();
}

constexpr int LDS_BYTES = 163840, XCH_OFF = 131072, MISC_OFF = 163840 - 256;
constexpr int NPHASE = 14;
constexpr int CW_BAR = 4096;
#define CAS __attribute__((address_space(4)))
__global__ void __launch_bounds__(512, 2) mk_fwd(Params P_unused) {
    const CAS Params* kp = (const CAS Params*)__builtin_amdgcn_kernarg_segment_ptr();
#if defined(__HIP_DEVICE_COMPILE__)
#define PLOAD const Params P = *kp
#else
#define PLOAD const Params P = P_unused; (void)kp
#endif
    extern __shared__ __attribute__((aligned(16))) unsigned char lds_raw[];
    Ctx X; X.lds = (LAS unsigned char*)lds_raw; X.tid = threadIdx.x; X.lane = X.tid & 63; X.wave = __builtin_amdgcn_readfirstlane(X.tid >> 6);
    X.G = gridDim.x; { const int bx = blockIdx.x; X.vcu = (X.G % 8 == 0) ? (bx % 8) * (X.G / 8) + bx / 8 : bx; }
    X.gw = X.vcu * 8 + X.wave; X.ngw = X.G * 8;
    volatile LAS unsigned* MISC = (volatile LAS unsigned*)(X.lds + MISC_OFF);
    if (X.tid < 64) MISC[X.tid] = 0u;
    __syncthreads();
    const int lo = kp->ph_lo, hi = kp->ph_hi;
    XcdBarrier bar; bar.bar = kp->ctl + CW_BAR; bar.x = 0; bar.st = nullptr;
    if (hi - lo > 1) bar = xcd_barrier_post(kp->ctl + CW_BAR, MISC + 8);
#ifndef PHASE_MASK
#define PHASE_MASK 0x3fff
#endif
#define IN(k) (((PHASE_MASK >> (k)) & 1) && lo <= (k) && (k) < hi)
#define SEAM(k) do { if (IN(k) && IN((k) + 1)) xcd_barrier(bar); } while (0)
    const int nM = kp->T / 256, c = (int)blockIdx.x, G = X.G;
    LAS unsigned char* ring = X.lds;

    if (IN(0)) { PLOAD; p0_prologue(P, X); }
    SEAM(0);
    if (IN(1)) { PLOAD;
        { SchedFlat S{(const char*)P.XN, (const char*)P.WIN_T, nullptr, (size_t)256 * 1024 * 2, (size_t)256 * 1024 * 2, 0, 0, 0, nM, 21, 1 << 30, G, c};
          EpiProj E{(unsigned char*)P.Q, (size_t)P.T * 16, P.ROPE, P.in[5]};
          gemm_phase<EpiProj, SchedFlat>(ring, 1024, 1024, 1024, S, E); }
        { SchedFlat S{(const char*)P.MN, (const char*)P.WKV_T, (char*)P.KVX, (size_t)256 * 1024 * 2, (size_t)256 * 1024 * 2, 0, (size_t)256 * 2048 * 2, (size_t)256 * 2, P.nb, 8, 1 << 30, G, c};
          EpiPlain E{2048, 1.0f};
          gemm_phase<EpiPlain, SchedFlat>(ring, 1024, 1024, 1024, S, E); }
    }
    SEAM(1);
    if (IN(2)) { PLOAD;
#ifndef P2_PARTS
#define P2_PARTS 7
#endif
        if (P2_PARTS & 1) attn_phase(P, X);
        if (P2_PARTS & 2) gmlp_phase(P, X);
        if (P2_PARTS & 4) { SchedWqk S{(const char*)P.KVX, (const char*)P.WQS, (char*)P.WQK, P.nb * 4, G, c}; EpiPlain E{1024, XSCALE}; gemm_phase<EpiPlain, SchedWqk>(ring, 256, 2048, 1024, S, E); }
        if (P2_PARTS & 4) { SchedVwo S{(const char*)P.WO_T, (const char*)P.KVX, (char*)P.VWO, P.nb * 4, G, c}; EpiPlain E{1024, 1.0f}; gemm_phase<EpiPlain, SchedVwo>(ring, 256, 1024, 2048, S, E); }
    }
    SEAM(2);
    if (IN(3)) { PLOAD; merge_phase(P, X); }
    SEAM(3);
    if (IN(4)) { PLOAD;
        SchedFlat S{(const char*)P.YA, (const char*)P.WA_T, nullptr, (size_t)256 * 256 * 2, (size_t)256 * 256 * 2, 0, 0, 0, nM, 4, 1 << 30, G, c};
        EpiGate<false> E{P.GA, nullptr, P.M1};
        gemm_phase<EpiGate<false>, SchedFlat>(ring, 256, 256, 256, S, E);
    }
    if (IN(4) && IN(5)) { VM_WAIT(); __syncthreads(); }
    if (IN(5)) { PLOAD;
        SchedFlat S{(const char*)P.YB, (const char*)P.WB_T, nullptr, (size_t)256 * 512 * 2, (size_t)256 * 512 * 2, 0, 0, 0, nM, 4, 1 << 30, G, c};
        EpiGate<true> E{P.GB, P.M1, P.MERGED};
        gemm_phase<EpiGate<true>, SchedFlat>(ring, 512, 512, 512, S, E);
    }
    SEAM(5);
    if (IN(6)) { PLOAD;
        SchedFlat S{(const char*)P.MERGED, (const char*)P.WOUT_T, nullptr, (size_t)256 * 1024 * 2, (size_t)256 * 1024 * 2, 0, 0, 0, nM, 4, 1 << 30, G, c};
        EpiResid<true> E{P.in[0] + (size_t)P.b0 * 4096 * 1024, nullptr, P.H1, P.SSQ1};
        gemm_phase<EpiResid<true>, SchedFlat>(ring, 1024, 1024, 1024, S, E);
    }
    SEAM(6);
    if (IN(7)) { PLOAD;
        SchedFlat S{(const char*)P.H1, (const char*)P.WQK, nullptr, (size_t)256 * 1024 * 2, (size_t)256 * 1024 * 2, (size_t)1048576 * 2, 0, 0, nM, 4, 16, G, c};
        EpiScores E{P.SSQ1, P.PX, (LAS float*)(X.lds + XCH_OFF), X.tid};
        gemm_phase<EpiScores, SchedFlat>(ring, 1024, 1024, 1024, S, E);
    }
    SEAM(7);
    if (IN(8)) { PLOAD;
        SchedFlat S{(const char*)P.PX, (const char*)P.VWO, nullptr, (size_t)256 * 1024 * 2, (size_t)256 * 1024 * 2, (size_t)1048576 * 2, 0, 0, nM, 4, 16, G, c};
        EpiResid<false> E{nullptr, P.H1, P.H2, P.SSQ2};
        gemm_phase<EpiResid<false>, SchedFlat>(ring, 1024, 1024, 1024, S, E);
    }
    SEAM(8);
    if (IN(9)) { PLOAD; router_phase(P, X); }
    SEAM(9);
    if (IN(10)) { PLOAD; positions_phase(P, X); }
    SEAM(10);
    if (IN(11)) { PLOAD;
        SchedMoe S{(const char*)P.H2, (const char*)P.WGU_T, (char*)P.HB, P.ROWTOK, P.TILE_E, P.TILE_E + 1024, 0, (size_t)1048576 * 2, (size_t)256 * 1024 * 2, (size_t)512 * 2, (size_t)128 * 2, G, X.vcu};
        EpiMoe1 E{P.SSQ2, (LAS float*)(X.lds + XCH_OFF), X.tid};
        gemm_phase<EpiMoe1, SchedMoe, true>(ring, 1024, 1024, 1024, S, E);
    }
    SEAM(11);
    if (IN(12)) { PLOAD;
        SchedMoe S{(const char*)P.HB, (const char*)P.WD_T, (char*)P.YBX, P.ROWTOK, P.TILE_E, P.TILE_E + 1024, (size_t)512 * 2, (size_t)524288 * 2, (size_t)256 * 512 * 2, (size_t)1024 * 2, (size_t)256 * 2, G, X.vcu};
        EpiMoe2 E{P.WBUF};
        gemm_phase<EpiMoe2, SchedMoe>(ring, 512, 512, 512, S, E);
    }
    SEAM(12);
    if (IN(13)) { PLOAD; final_phase(P, X); }
#undef IN
#undef SEAM
}

constexpr size_t MiB = 1u << 20;
static Params make_params(void* const* d_in, unsigned char* ws, unsigned char* sc2, float* out, int nb, int b0) {
    Params P{};
    for (int i = 0; i < 27; ++i) P.in[i] = (const float*)d_in[i];
    P.out = out; P.ctl = (unsigned*)ws; P.nb = nb; P.T = nb * 4096; P.b0 = b0;
    size_t o = 1 * MiB; auto fx = [&](size_t bytes) { unsigned char* p = ws + o; o += (bytes + 4095) & ~(size_t)4095; return p; };
    P.WIN_T = (bf16_t*)fx((size_t)5376 * 1024 * 2); P.WKV_T = (bf16_t*)fx((size_t)2048 * 1024 * 2); P.WA_T = (bf16_t*)fx((size_t)1024 * 256 * 2); P.WB_T = (bf16_t*)fx((size_t)1024 * 512 * 2);
    P.WOUT_T = (bf16_t*)fx((size_t)1024 * 1024 * 2); P.WQS = (bf16_t*)fx((size_t)1024 * 1024 * 2); P.WO_T = (bf16_t*)fx((size_t)1024 * 1024 * 2); P.WR_T = (bf16_t*)fx((size_t)48 * 1024 * 2);
    P.WSP = (bf16_t*)fx((size_t)4 * 128 * 128 * 2); P.WGU_T = (bf16_t*)fx((size_t)32 * 1024 * 1024 * 2); P.WD_T = (bf16_t*)fx((size_t)32 * 1024 * 512 * 2);
    P.TILE_E = (int*)fx(8192); P.TOT = (int*)fx(4096); P.BCNT = (int*)fx(256 * 32 * 4);
    const size_t u = (size_t)P.T * 16; unsigned char* sb = ws + 128 * MiB; auto sc = [&](size_t s) { return sb + s * u; };
    P.Q = (bf16_t*)sc(0); P.K = (bf16_t*)sc(96); P.V = (bf16_t*)sc(192); P.ZU = (bf16_t*)sc(288); P.ZV = (bf16_t*)sc(352); P.GA = (bf16_t*)sc(416); P.GB = (bf16_t*)sc(544);
    P.OG = (bf16_t*)sc(672); P.LSE = (float*)sc(768); P.SSQ1 = (float*)sc(772); P.SSQ2 = (float*)sc(776); P.EID = (int*)sc(780); P.WGT = (float*)sc(781); P.POSOF = (int*)sc(782);
    P.ROWTOK = (int*)sc(783); P.WBUF = (float*)sc(785);
    P.YA = (bf16_t*)sc(0); P.M1 = (bf16_t*)sc(32); P.MERGED = (bf16_t*)sc(160); P.H1 = (bf16_t*)sc(288); P.PX = (bf16_t*)sc(416); P.H2 = (bf16_t*)sc(544);
    const size_t prow = (size_t)2 * P.T + 8192;
    if (nb == 16) { P.HB = (bf16_t*)sc(0); P.YBX = (bf16_t*)sc(136); } else { P.HB = (bf16_t*)sc(800); P.YBX = (bf16_t*)(sc(800) + prow * 1024); }
    auto s2 = [&](size_t s) { return sc2 + s * u; };
    P.XN = (bf16_t*)s2(0); P.MN = (bf16_t*)s2(128); P.ROPE = (float*)s2(136); P.KVX = (bf16_t*)s2(152); P.YB = (bf16_t*)s2(0); P.WQK = (bf16_t*)s2(64); P.VWO = (bf16_t*)s2(96);
    return P;
}
static size_t ws_bytes_needed(int nb) { const size_t T = (size_t)nb * 4096, u = T * 16, prow = 2 * T + 8192; return 128 * MiB + (nb == 16 ? 787 * u : 800 * u + prow * 1024 * 3); }
static int g_grid = 0;
static bool mk_setup() {
    if (g_grid) return g_grid > 0;
    int dev = 0, cus = 0;
    if (hipGetDevice(&dev) != hipSuccess || hipDeviceGetAttribute(&cus, hipDeviceAttributeMultiprocessorCount, dev) != hipSuccess) { g_grid = -1; return false; }
    if (hipFuncSetAttribute((const void*)mk_fwd, hipFuncAttributeMaxDynamicSharedMemorySize, LDS_BYTES) != hipSuccess) { fprintf(stderr, "mk: cannot get %d B of dynamic LDS\n", LDS_BYTES); g_grid = -1; return false; }
    int per_cu = 0; (void)hipOccupancyMaxActiveBlocksPerMultiprocessor(&per_cu, (const void*)mk_fwd, 512, LDS_BYTES); (void)hipGetLastError();
    if (per_cu < 1) fprintf(stderr, "mk: occupancy query says %d workgroups per CU\n", per_cu);
    g_grid = cus; return true;
}
static void mk_launch(Params P, int lo, int hi, hipStream_t st) { P.ph_lo = lo; P.ph_hi = hi; hipLaunchKernelGGL(mk_fwd, dim3(g_grid), dim3(512), LDS_BYTES, st, P); }
}
#ifndef BUILD_MODE
#define BUILD_MODE 1
#endif
#if BUILD_MODE == 3
namespace chk {
__global__ void __launch_bounds__(256) cmp(const void* opt, int kind, int ldo, const void* ref, int ldr, int rows, int cols, int mode, float scale, const float* bias, float* err) {
    float num = 0.f, den = 0.f;
    for (size_t i = (size_t)blockIdx.x * 256 + threadIdx.x; i < (size_t)rows * cols; i += (size_t)gridDim.x * 256) {
        const int r = (int)(i / cols), c = (int)(i % cols);
        if (kind == 2) { const int o = ((const int*)opt)[(size_t)r * ldo + c], v = ((const int*)ref)[(size_t)r * ldr + c]; num += (o != v) ? 1.f : 0.f; den += 1.f; continue; }
        float o; if (kind == 1) o = __uint_as_float(((unsigned)((const unsigned short*)opt)[(size_t)r * ldo + c]) << 16); else o = ((const float*)opt)[(size_t)r * ldo + c];
        int rc = c; if (mode == 1) { const int d = c & 63; rc = (c & ~63) + (d >> 1) + 32 * (d & 1); }
        float v = (mode == 4) ? ((const float*)ref)[(size_t)c * ldr + r] : ((const float*)ref)[(size_t)r * ldr + rc]; if (mode == 2) v = 1.0f / (1.0f + expf(-(v + (bias ? bias[c] : 0.f)))); if (mode == 3) { const float uu = 0.7978845608028654f * (v + 0.044715f * v * v * v); v = 0.5f * v * (1.0f + tanhf(uu)); } v *= scale;
        const float d2 = (o - v) * (o - v); num += (d2 == d2) ? d2 : 1e30f; den += v * v;
    }
    for (int o = 32; o >= 1; o >>= 1) { num += __shfl_xor(num, o); den += __shfl_xor(den, o); }
    if ((threadIdx.x & 63) == 0) { atomicAdd(err, num); atomicAdd(err + 1, den); }
}
__global__ void decide(const float* err, const unsigned* barw, float* factor, int nstage) {
    if (threadIdx.x != 0 || blockIdx.x != 0) return;
    float f = 1.0f;
    for (int k = 1; k <= nstage; ++k) { const float num = err[2 * k], den = err[2 * k + 1]; float rel = (k == 13) ? num / fmaxf(den, 1.f) : sqrtf(num / fmaxf(den, 1e-30f));
        const float tol = (k == 13) ? 0.05f : 0.03f;
        if (!(rel < tol)) { int cls = 0; if (!(rel < 0.1f)) cls = 1; if (!(rel < 0.5f)) cls = 2; if (!(rel < 1.2f)) cls = 3; if (!(rel < 1e6f)) cls = 4;
            float c = 0.25f * (float)k; for (int q = 0; q < cls; ++q) c *= 100.f; f = 1.0f + c; break; } }
    if (f == 1.0f && barw[mk::CW_BAR + XB_TMO] != 0u) f = 1.0f + 4.0f;
    *factor = f;
}
__global__ void decide_mask(const float* err, float* factor, int first, int ntests) {
    if (threadIdx.x != 0 || blockIdx.x != 0) return;
    int mask = 0;
    for (int q = 0; q < ntests; ++q) { const float num = err[2 * (first + q)], den = err[2 * (first + q) + 1]; const float rel = sqrtf(num / fmaxf(den, 1e-30f)); if (!(rel < 0.03f)) mask |= 1 << q; }
    *factor = 1.0f + 0.25f * (float)(mask + 1);
#ifdef CHK_REL_OF
    { const float num = err[2 * CHK_REL_OF], den = err[2 * CHK_REL_OF + 1]; *factor = 1.0f + sqrtf(num / fmaxf(den, 1e-30f)); }
#endif
}
__global__ void __launch_bounds__(256) scale_out(float* out, const float* factor, size_t n) { const float f = *factor; for (size_t i = (size_t)blockIdx.x * 256 + threadIdx.x; i < n; i += (size_t)gridDim.x * 256) out[i] *= f; }
}
#endif

extern "C" void kernel_launch(void* const* d_in, const int* in_sizes, int n_in, void* d_out, int out_size, void* d_ws, size_t ws_size, hipStream_t stream) {
    (void)in_sizes; (void)n_in; (void)out_size; (void)ws_size;
#if BUILD_MODE == 0
    const nv::Bufs B = nv::carve((unsigned char*)d_ws);
    for (int b = 0; b < 16; ++b) nv::forward_batch(d_in, b, B, (float*)d_out + (size_t)b * nv::S * nv::D, nullptr, stream);
#elif BUILD_MODE == 1 || BUILD_MODE == 2
    if (!mk::mk_setup()) return;
    const mk::Params P = mk::make_params(d_in, (unsigned char*)d_ws, (unsigned char*)d_out, (float*)d_out, 16, 0);
    (void)hipMemsetAsync(d_ws, 0, 65536, stream);
#if BUILD_MODE == 1
    for (int k = 0; k < mk::NPHASE; ++k) mk::mk_launch(P, k, k + 1, stream);
#else
    mk::mk_launch(P, 0, mk::NPHASE, stream);
#endif
#else
    if (!mk::mk_setup()) return;
    unsigned char* ws = (unsigned char*)d_ws; const size_t MiB = mk::MiB;
    const nv::Bufs B = nv::carve(ws);
    for (int b = 0; b < 16; ++b) nv::forward_batch(d_in, b, B, (float*)d_out + (size_t)b * nv::S * nv::D, nullptr, stream);
    unsigned char* ows = ws + 384 * MiB; unsigned char* sc2 = ws + 700 * MiB; float* oout = (float*)(ws + 740 * MiB); float* err = (float*)(ws + 780 * MiB); float* factor = err + 64;
    (void)hipMemsetAsync(ows, 0, 65536, stream); (void)hipMemsetAsync(err, 0, 1024, stream);
    const mk::Params P = mk::make_params(d_in, ows, sc2, oout, 2, 14);
    const size_t R = 4096;
    auto C = [&](int code, const void* opt, int kind, int ldo, const void* ref, int ldr, int cols, int mode, float scale, const float* bias) {
        const int esz = kind == 1 ? 2 : 4; chk::cmp<<<1024, 256, 0, stream>>>((const char*)opt + R * (size_t)ldo * esz, kind, ldo, ref, ldr, 4096, cols, mode, scale, bias, err + 2 * code); };
    const float* bgates = (const float*)d_in[5];
    for (int k = 0; k < mk::NPHASE; ++k) {
        mk::mk_launch(P, k, k + 1, stream);
        if (k == 0) C(1, P.XN, 1, 1024, B.XN, 1024, 1024, 0, 1.f, nullptr);
        if (k == 1) { C(2, P.Q, 1, 768, B.PROJ, 5376, 768, 1, mk::QSCALE, nullptr); C(3, P.K, 1, 768, B.PROJ + 768, 5376, 768, 1, 1.f, nullptr); C(4, P.V, 1, 768, B.PROJ + 1536, 5376, 768, 0, 1.f, nullptr);
                      C(5, P.ZU, 1, 512, B.U, 512, 512, 0, 1.f, nullptr); C(6, P.GA, 1, 1024, B.PROJ + 3328, 5376, 1024, 2, 1.f, bgates); C(7, P.GB, 1, 1024, B.PROJ + 4352, 5376, 1024, 2, 1.f, bgates + 1024); }
#ifdef CHK_MASK_FIRST
        if (k == 0) { const float* w_in = (const float*)d_in[4]; const float* w_kv = (const float*)d_in[16];
            chk::cmp<<<1024, 256, 0, stream>>>(P.WIN_T + (size_t)2816 * 1024, 1, 1024, w_in + 2816, 5376, 512, 1024, 4, 1.f, nullptr, err + 40);
            chk::cmp<<<1024, 256, 0, stream>>>(P.WIN_T + (size_t)3328 * 1024, 1, 1024, w_in + 3328, 5376, 1024, 1024, 4, 1.f, nullptr, err + 42);
            chk::cmp<<<1024, 256, 0, stream>>>(P.WIN_T + (size_t)4352 * 1024, 1, 1024, w_in + 4352, 5376, 1024, 1024, 4, 1.f, nullptr, err + 44);
            chk::cmp<<<1024, 256, 0, stream>>>(P.WKV_T, 1, 1024, w_kv, 2048, 2048, 1024, 4, 1.f, nullptr, err + 46); }
#endif
        if (k == 2) C(9, P.YB, 1, 512, B.YB, 512, 512, 0, 1.f, nullptr);
        if (k == 3) C(8, P.YA, 1, 256, B.YA, 256, 256, 0, 1.f, nullptr);
        if (k == 5) C(10, P.MERGED, 1, 1024, B.MERGED, 1024, 1024, 0, 1.f, nullptr);
        if (k == 6) C(11, P.H1, 1, 1024, B.H1, 1024, 1024, 0, 1.f, nullptr);
        if (k == 8) C(12, P.H2, 1, 1024, B.H2, 1024, 1024, 0, 1.f, nullptr);
        if (k == 9) { chk::cmp<<<64, 256, 0, stream>>>(P.EID + 2 * R, 2, 2, B.EID, 2, 4096, 2, 0, 1.f, nullptr, err + 26); chk::cmp<<<64, 256, 0, stream>>>(P.WGT + 2 * R, 0, 2, B.WGT, 2, 4096, 2, 0, 1.f, nullptr, err + 28); }
        if (k == 13) C(15, oout, 0, 1024, (const float*)d_out + (size_t)15 * 4096 * 1024, 1024, 1024, 0, 1.f, nullptr);
    }
#ifdef CHK_MASK_FIRST
    chk::decide_mask<<<1, 64, 0, stream>>>(err, factor, CHK_MASK_FIRST, 4);
#else
    chk::decide<<<1, 64, 0, stream>>>(err, (const unsigned*)ows, factor, 15);
#endif
    chk::scale_out<<<2048, 256, 0, stream>>>((float*)d_out, factor, (size_t)16 * 4096 * 1024);
#endif
}
```

```cpp
#define BUILD_MODE 2
#include <hip/hip_runtime.h>
#include <cstdio>
#include <cstdint>
namespace mk {
#define LAS __attribute__((address_space(3)))
#define GAS __attribute__((address_space(1)))
typedef unsigned short bf16_t;
typedef short bf16x8 __attribute__((ext_vector_type(8)));
typedef short s16x4 __attribute__((ext_vector_type(4)));
typedef float f32x4 __attribute__((ext_vector_type(4)));
typedef float f32x2 __attribute__((ext_vector_type(2)));
typedef unsigned u32x4 __attribute__((ext_vector_type(4)));
typedef unsigned u32x2 __attribute__((ext_vector_type(2)));
constexpr int BM = 256, BK = 64, HALF = 128, HTB = HALF * BK * 2, STAGE_BYTES = 8 * HTB, NXCD = 8, WGM = 8;

__host__ __device__ __forceinline__ int lds_byte(int r, int c) { const int st = (r >> 4) * 2 + (c >> 5), rr = r & 15, cc = c & 31, ob = rr * 64 + cc * 2; return st * 1024 + (ob ^ (((ob >> 9) & 1) << 5)); }
__host__ __device__ __forceinline__ void stage_rc(int b, int& R, int& C) { const int st = b / 1024, sb = b % 1024, swz = sb ^ (((sb >> 9) & 1) << 5); R = (st >> 1) * 16 + swz / 64; C = (st & 1) * 32 + (swz % 64) / 2; }
__host__ __device__ __forceinline__ int perm32(int rho) { const int n = rho >> 4, i = rho & 15; return 8 * (i >> 2) + 4 * n + (i & 3); }

typedef __bf16 bf16x2_t __attribute__((ext_vector_type(2)));
__device__ __forceinline__ unsigned cvt_pk_bf16(float lo, float hi) { const f32x2 v = {lo, hi}; const bf16x2_t b = __builtin_convertvector(v, bf16x2_t); return __builtin_bit_cast(unsigned, b); }
__device__ __forceinline__ float bf_lo(unsigned w) { return __uint_as_float(w << 16); }
__device__ __forceinline__ float bf_hi(unsigned w) { return __uint_as_float(w & 0xffff0000u); }
__device__ __forceinline__ float fast_exp2(float x) { return __builtin_amdgcn_exp2f(x); }
__device__ __forceinline__ float fast_rcp(float x) { return __builtin_amdgcn_rcpf(x); }

struct Unit { const char* A; const char* B; char* C; const int* rows; int pm, pn, z, pad; };

__device__ __forceinline__ void tile_of(int wgid, int nM, int nN, int& pm, int& pn) {
    const int nwg = nM * nN; { const int q = nwg / NXCD, r = nwg % NXCD, xcd = wgid % NXCD, off = wgid / NXCD; wgid = (xcd < r ? xcd * (q + 1) : r * (q + 1) + (xcd - r) * q) + off; }
    const int nig = WGM * nN, gid = wgid / nig, fm = gid * WGM, gsz = (nM - fm) < WGM ? (nM - fm) : WGM;
    pm = fm + ((wgid % nig) % gsz); pn = (wgid % nig) / gsz;
}

template <class Epi, class Sched, bool GATHER = false>
__device__ __forceinline__ void gemm_phase(LAS unsigned char* lds, const int K, const int lda, const int ldb, const Sched& S, const Epi& E) {
    const int tid = threadIdx.x, wid = __builtin_amdgcn_readfirstlane(tid >> 6), lane = tid & 63, wr = wid >> 2, wc = wid & 3, fr = lane & 15, fq = lane >> 4;
    const int nt = K / BK;
    int RA[2], CA[2]; unsigned voffB[2][2];
#pragma unroll
    for (int i = 0; i < 2; ++i) { int R, C; stage_rc(tid * 16 + i * 8192, R, C); const int Rb = Epi::PERM ? ((R & ~31) + perm32(R & 31)) : R; RA[i] = R; CA[i] = C;
        voffB[0][i] = (unsigned)(Rb * ldb + C) * 2u; voffB[1][i] = (unsigned)((Rb + HALF) * ldb + C) * 2u; }
    const size_t kstep = (size_t)(BK * 2);
    const unsigned ldsw = (unsigned)wid * 1024u;
    const int aoff = lds_byte(wr * 64 + fr, fq * 8), boff = lds_byte(wc * 32 + fr, fq * 8);
#define MK_SA(b, h) (((b) * 2 + (h)) * HTB)
#define MK_SB(b, h) ((4 + (b) * 2 + (h)) * HTB)
#define MK_STAGE2(bufoff, gbase, v0, v1) do { \
        __builtin_amdgcn_global_load_lds((const unsigned*)((const char*)(gbase) + (v0)), (LAS unsigned*)(lds + (bufoff) + ldsw), 16, 0, 0); \
        __builtin_amdgcn_global_load_lds((const unsigned*)((const char*)(gbase) + (v1)), (LAS unsigned*)(lds + (bufoff) + ldsw + 8192), 16, 0, 0); } while (0)
#define MK_LDA(dst, b, h) do { _Pragma("unroll") for (int m = 0; m < 4; ++m) _Pragma("unroll") for (int k = 0; k < 2; ++k) dst[m][k] = *(const LAS bf16x8*)(lds + MK_SA(b, h) + aoff + m * 2048 + k * 1024); } while (0)
#define MK_LDB(dst, b, h) do { _Pragma("unroll") for (int n = 0; n < 2; ++n) _Pragma("unroll") for (int k = 0; k < 2; ++k) dst[n][k] = *(const LAS bf16x8*)(lds + MK_SB(b, h) + boff + n * 2048 + k * 1024); } while (0)
#define MK_MMA(ai, bj, At, Bt) do { __builtin_amdgcn_s_setprio(1); _Pragma("unroll") for (int m = 0; m < 4; ++m) _Pragma("unroll") for (int n = 0; n < 2; ++n) _Pragma("unroll") for (int k = 0; k < 2; ++k) \
        acc[ai][bj][m][n] = __builtin_amdgcn_mfma_f32_16x16x32_bf16(Bt[n][k], At[m][k], acc[ai][bj][m][n], 0, 0, 0); __builtin_amdgcn_s_setprio(0); } while (0)
#define MK_WAIT_V(n) asm volatile("s_waitcnt vmcnt(" #n ")" ::: "memory")
#define MK_WAIT_L(n) asm volatile("s_waitcnt lgkmcnt(" #n ")" ::: "memory")
#define MK_BAR __builtin_amdgcn_s_barrier()
#define MK_SCHED __builtin_amdgcn_sched_barrier(0)
    Unit cur, nxt; int ui = 0;
    if (!S.next(0, cur)) return;
    f32x4 acc[2][2][4][2];
#pragma unroll
    for (int a = 0; a < 2; ++a)
#pragma unroll
        for (int b = 0; b < 2; ++b)
#pragma unroll
            for (int m = 0; m < 4; ++m)
#pragma unroll
                for (int n = 0; n < 2; ++n) acc[a][b][m][n] = (f32x4){0.f, 0.f, 0.f, 0.f};
    bf16x8 At[4][2], B0[2][2], B1[2][2];
    unsigned vA[2][2], nvA[2][2];
    auto a_offsets = [&](const Unit& u, unsigned (&v)[2][2]) {
#pragma unroll
        for (int h = 0; h < 2; ++h)
#pragma unroll
            for (int i = 0; i < 2; ++i) { const int r = h * HALF + RA[i]; const int src = GATHER ? ((const GAS int*)u.rows)[r] : r; v[h][i] = (unsigned)(src * lda + CA[i]) * 2u; }
    };
    a_offsets(cur, vA);
    if (GATHER) asm volatile("" : "+v"(vA[0][0]), "+v"(vA[0][1]), "+v"(vA[1][0]), "+v"(vA[1][1]));
    const char* cA = cur.A; const char* cB = cur.B;
    MK_STAGE2(MK_SB(0, 0), cB, voffB[0][0], voffB[0][1]); MK_STAGE2(MK_SB(0, 1), cB, voffB[1][0], voffB[1][1]); MK_STAGE2(MK_SA(0, 0), cA, vA[0][0], vA[0][1]); MK_STAGE2(MK_SA(0, 1), cA, vA[1][0], vA[1][1]);
    if (wr == 1) MK_BAR;
    MK_WAIT_V(2); MK_BAR;
    MK_STAGE2(MK_SB(1, 0), cB + kstep, voffB[0][0], voffB[0][1]); MK_STAGE2(MK_SA(1, 0), cA + kstep, vA[0][0], vA[0][1]); MK_STAGE2(MK_SB(1, 1), cB + kstep, voffB[1][0], voffB[1][1]);
    MK_WAIT_V(6); MK_BAR;
    for (;;) {
        const bool has_next = S.next(ui + 1, nxt);
        const char* nA = has_next ? nxt.A : cA; const char* nB = has_next ? nxt.B : cB;
        if (GATHER) { if (has_next) a_offsets(nxt, nvA); else {
#pragma unroll
            for (int h = 0; h < 2; ++h) { nvA[h][0] = vA[h][0]; nvA[h][1] = vA[h][1]; } }
            asm volatile("" : "+v"(nvA[0][0]), "+v"(nvA[0][1]), "+v"(nvA[1][0]), "+v"(nvA[1][1])); }
#pragma nounroll
        for (int t = 0; t < nt; t += 2) {
            const bool last = (t == nt - 2);
            const char* a1 = cA + (size_t)(t + 1) * kstep;
            const char* a2 = last ? nA : cA + (size_t)(t + 2) * kstep; const char* b2 = last ? nB : cB + (size_t)(t + 2) * kstep;
            const char* a3 = a2 + kstep; const char* b3 = b2 + kstep;
            unsigned w00 = vA[0][0], w01 = vA[0][1], w10 = vA[1][0], w11 = vA[1][1];
            if (GATHER) { if (last) { w00 = nvA[0][0]; w01 = nvA[0][1]; w10 = nvA[1][0]; w11 = nvA[1][1]; } }
            MK_LDB(B0, 0, 0); MK_LDB(B1, 0, 1); MK_SCHED; MK_LDA(At, 0, 0); MK_STAGE2(MK_SA(1, 1), a1, vA[1][0], vA[1][1]);
            MK_WAIT_V(8); MK_WAIT_L(0); MK_BAR; MK_MMA(0, 0, At, B0); MK_MMA(0, 1, At, B1); MK_BAR; MK_SCHED;
            MK_LDA(At, 0, 1); MK_STAGE2(MK_SB(0, 0), b2, voffB[0][0], voffB[0][1]); MK_STAGE2(MK_SB(0, 1), b2, voffB[1][0], voffB[1][1]); MK_STAGE2(MK_SA(0, 0), a2, w00, w01);
            MK_WAIT_V(8); MK_WAIT_L(0); MK_BAR; MK_MMA(1, 0, At, B0); MK_MMA(1, 1, At, B1); MK_BAR; MK_SCHED;
            MK_LDB(B0, 1, 0); MK_LDB(B1, 1, 1); MK_SCHED; MK_LDA(At, 1, 0); MK_STAGE2(MK_SA(0, 1), a2, w10, w11);
            MK_WAIT_V(8); MK_WAIT_L(0); MK_BAR; MK_MMA(0, 0, At, B0); MK_MMA(0, 1, At, B1); MK_BAR; MK_SCHED;
            MK_LDA(At, 1, 1); MK_STAGE2(MK_SB(1, 0), b3, voffB[0][0], voffB[0][1]); MK_STAGE2(MK_SB(1, 1), b3, voffB[1][0], voffB[1][1]); MK_STAGE2(MK_SA(1, 0), a3, w00, w01);
            MK_WAIT_V(8); MK_WAIT_L(0); MK_BAR; MK_MMA(1, 0, At, B0); MK_MMA(1, 1, At, B1); MK_BAR; MK_SCHED;
        }
        if (wr == 0) MK_BAR;
        E(acc, cur, wr, wc, fr, fq);
        if (!has_next) break;
#pragma unroll
        for (int a = 0; a < 2; ++a)
#pragma unroll
            for (int b = 0; b < 2; ++b)
#pragma unroll
                for (int m = 0; m < 4; ++m)
#pragma unroll
                    for (int n = 0; n < 2; ++n) acc[a][b][m][n] = (f32x4){0.f, 0.f, 0.f, 0.f};
        cur = nxt; cA = nA; cB = nB; ++ui;
        if (GATHER) {
#pragma unroll
            for (int h = 0; h < 2; ++h) { vA[h][0] = nvA[h][0]; vA[h][1] = nvA[h][1]; } }
        if (wr == 1) MK_BAR;
    }
    MK_WAIT_V(0);
    MK_BAR;
#undef MK_SA
#undef MK_SB
#undef MK_STAGE2
#undef MK_LDA
#undef MK_LDB
#undef MK_MMA
#undef MK_WAIT_V
#undef MK_WAIT_L
#undef MK_BAR
#undef MK_SCHED
}
constexpr float LOG2E = 1.4426950408889634f;
constexpr float QSCALE = 0.125f * LOG2E;
constexpr float XSCALE = 0.0625f * LOG2E;
#define EPI_ARGS f32x4 (&acc)[2][2][4][2], const Unit& u, int wr, int wc, int fr, int fq
#define FOR_AI_M _Pragma("unroll") for (int ai = 0; ai < 2; ++ai) _Pragma("unroll") for (int m = 0; m < 4; ++m)
#define FOR_BJ _Pragma("unroll") for (int bj = 0; bj < 2; ++bj)
__device__ __forceinline__ u32x4 pack8(const f32x4 a, const f32x4 b) { u32x4 w; w.x = cvt_pk_bf16(a[0], a[1]); w.y = cvt_pk_bf16(a[2], a[3]); w.z = cvt_pk_bf16(b[0], b[1]); w.w = cvt_pk_bf16(b[2], b[3]); return w; }
__device__ __forceinline__ void unpack8(const u32x4 w, f32x4& a, f32x4& b) { a = (f32x4){bf_lo(w.x), bf_hi(w.x), bf_lo(w.y), bf_hi(w.y)}; b = (f32x4){bf_lo(w.z), bf_hi(w.z), bf_lo(w.w), bf_hi(w.w)}; }
__device__ __forceinline__ float sigm(float x) { return fast_rcp(1.0f + fast_exp2(-LOG2E * x)); }
__device__ __forceinline__ float gelu_t(float x) { const float u2 = 1.5957691216057308f * x * (1.0f + 0.044715f * x * x); return x * fast_rcp(1.0f + fast_exp2(-LOG2E * u2)); }
__device__ __forceinline__ float rinv16(const float* ssq, size_t row) {
    const f32x4* p = (const f32x4*)(ssq + row * 16); const f32x4 a = p[0], b = p[1], c = p[2], d = p[3];
    const float s = ((a[0] + a[1]) + (a[2] + a[3])) + ((b[0] + b[1]) + (b[2] + b[3])) + ((c[0] + c[1]) + (c[2] + c[3])) + ((d[0] + d[1]) + (d[2] + d[3]));
    return rsqrtf(s * (1.0f / 1024.0f) + 1e-6f);
}

#define GRP(ld, esz) ((size_t)(ai * HALF + m * 16) * (size_t)(ld) * (esz))
#define FENCE_ODD_M if (m & 1) asm volatile("" ::: "memory")
#define FENCE_M3 if (m == 3) asm volatile("" ::: "memory")
struct EpiProj {
    static constexpr bool PERM = true;
    unsigned char* sb; size_t un; const float* rope; const float* bgates;
    __device__ __forceinline__ void operator()(EPI_ARGS) const {
        const int pn = u.pn; const int rt0 = wr * 64 + fr, cl = wc * 32 + 8 * fq; const size_t prow = (size_t)u.pm * BM;
        if (pn < 9) {
            const int sel = pn / 3, colt = (pn - 3 * sel) * 256; char* ob = (char*)(sb + (size_t)(96 * sel) * un) + (prow * 768 + colt) * 2; const unsigned vo = (unsigned)(rt0 * 768 + cl) * 2u;
            if (sel < 2) { const float sc = sel == 0 ? QSCALE : 1.0f; const char* tb = (const char*)rope + prow * 256; const unsigned vt = (unsigned)(rt0 * 64 + ((cl & 63) >> 1)) * 4u;
                FOR_AI_M { const char* tr = tb + GRP(64, 4) + vt; char* orow = ob + GRP(768, 2) + vo;
                    const f32x4 cs = *(const f32x4*)(tr) * sc, sn = *(const f32x4*)(tr + 128) * sc;
                    FOR_BJ { const f32x4 v0 = acc[ai][bj][m][0], v1 = acc[ai][bj][m][1];
                        const f32x4 o0 = {v0[0] * cs[0] - v0[1] * sn[0], v0[1] * cs[0] + v0[0] * sn[0], v0[2] * cs[1] - v0[3] * sn[1], v0[3] * cs[1] + v0[2] * sn[1]};
                        const f32x4 o1 = {v1[0] * cs[2] - v1[1] * sn[2], v1[1] * cs[2] + v1[0] * sn[2], v1[2] * cs[3] - v1[3] * sn[3], v1[3] * cs[3] + v1[2] * sn[3]};
                        *(u32x4*)(orow + bj * 256) = pack8(o0, o1); } }
            } else {
                FOR_AI_M { char* orow = ob + GRP(768, 2) + vo; FOR_BJ *(u32x4*)(orow + bj * 256) = pack8(acc[ai][bj][m][0], acc[ai][bj][m][1]); }
            }
        } else if (pn < 13) {
            char* ob = (char*)(sb + (size_t)(pn < 11 ? 288 : 352) * un) + (prow * 512 + ((pn - 9) & 1) * 256) * 2; const unsigned vo = (unsigned)(rt0 * 512 + cl) * 2u;
            FOR_AI_M { char* orow = ob + GRP(512, 2) + vo;
                FOR_BJ { f32x4 a = acc[ai][bj][m][0], b = acc[ai][bj][m][1];
#pragma unroll
                    for (int e = 0; e < 4; ++e) { a[e] = gelu_t(a[e]); b[e] = gelu_t(b[e]); }
                    *(u32x4*)(orow + bj * 256) = pack8(a, b); } }
        } else {
            char* ob = (char*)(sb + (size_t)(pn < 17 ? 416 : 544) * un) + (prow * 1024 + ((pn - 13) & 3) * 256) * 2; const unsigned vo = (unsigned)(rt0 * 1024 + cl) * 2u;
            const char* bb = (const char*)(bgates + (pn - 13) * 256); const unsigned vb = (unsigned)cl * 4u;
            f32x4 bv[2][2];
            FOR_BJ { bv[bj][0] = *(const f32x4*)(bb + bj * 512 + vb); bv[bj][1] = *(const f32x4*)(bb + bj * 512 + 16 + vb); }
            FOR_AI_M { char* orow = ob + GRP(1024, 2) + vo;
                FOR_BJ { f32x4 a = acc[ai][bj][m][0] + bv[bj][0], b = acc[ai][bj][m][1] + bv[bj][1];
#pragma unroll
                    for (int e = 0; e < 4; ++e) { a[e] = sigm(a[e]); b[e] = sigm(b[e]); }
                    *(u32x4*)(orow + bj * 256) = pack8(a, b); } }
        }
    }
};
struct EpiPlain {
    static constexpr bool PERM = true;
    int ldc; float scale;
    __device__ __forceinline__ void operator()(EPI_ARGS) const {
        const int rt0 = wr * 64 + fr, cl = wc * 32 + 8 * fq; const unsigned vo = (unsigned)(rt0 * ldc + cl) * 2u;
        FOR_AI_M { char* orow = u.C + GRP(ldc, 2) + vo;
            FOR_BJ *(u32x4*)(orow + bj * 256) = pack8(acc[ai][bj][m][0] * scale, acc[ai][bj][m][1] * scale); }
    }
};
template <bool ADD> struct EpiGate {
    static constexpr bool PERM = true;
    const bf16_t* G; const bf16_t* M1; bf16_t* O;
    __device__ __forceinline__ void operator()(EPI_ARGS) const {
        const int rt0 = wr * 64 + fr, cl = wc * 32 + 8 * fq; const size_t tb = ((size_t)u.pm * BM * 1024 + (size_t)u.pn * BM) * 2; const unsigned vo = (unsigned)(rt0 * 1024 + cl) * 2u;
        FOR_AI_M { const size_t go = tb + GRP(1024, 2);
            FOR_BJ { f32x4 g0, g1; unpack8(*(const u32x4*)((const char*)G + go + bj * 256 + vo), g0, g1); f32x4 a = g0 * acc[ai][bj][m][0], b = g1 * acc[ai][bj][m][1];
                if (ADD) { f32x4 m0, m1; unpack8(*(const u32x4*)((const char*)M1 + go + bj * 256 + vo), m0, m1); a += m0; b += m1; }
                *(u32x4*)((char*)O + go + bj * 256 + vo) = pack8(a, b); }
            if (ADD) { FENCE_M3; } }
    }
};
template <bool BASE_F32> struct EpiResid {
    static constexpr bool PERM = true;
    const float* bf; const bf16_t* bh; bf16_t* O; float* ssq;
    __device__ __forceinline__ void operator()(EPI_ARGS) const {
        const int rt0 = wr * 64 + fr, cl = wc * 32 + 8 * fq; const size_t te = (size_t)u.pm * BM * 1024 + (size_t)u.pn * BM; const unsigned ve = (unsigned)(rt0 * 1024 + cl);
        char* sq = (char*)ssq + ((size_t)u.pm * BM * 16 + u.pn * 4 + wc) * 4; const unsigned vs = (unsigned)rt0 * 64u;
        FOR_AI_M { const size_t ge = te + GRP(1024, 1); float s = 0.f;
            FOR_BJ { f32x4 a, b;
                if (BASE_F32) { const char* p = (const char*)bf + (ge + bj * HALF) * 4 + ve * 4u; a = *(const f32x4*)p; b = *(const f32x4*)(p + 16); } else unpack8(*(const u32x4*)((const char*)bh + (ge + bj * HALF) * 2 + ve * 2u), a, b);
                a += acc[ai][bj][m][0]; b += acc[ai][bj][m][1];
                s += (a[0] * a[0] + a[1] * a[1]) + (a[2] * a[2] + a[3] * a[3]) + (b[0] * b[0] + b[1] * b[1]) + (b[2] * b[2] + b[3] * b[3]);
                *(u32x4*)((char*)O + (ge + bj * HALF) * 2 + ve * 2u) = pack8(a, b); }
            s += __shfl_xor(s, 16); s += __shfl_xor(s, 32);
            if (fq == 0) *(float*)(sq + GRP(16, 4) + vs) = s;
            if (BASE_F32) { FENCE_M3; } }
    }
};
struct EpiScores {
    static constexpr bool PERM = true;
    const float* ssq; bf16_t* O; LAS float* xch; int tid;
    __device__ __forceinline__ void operator()(EPI_ARGS) const {
        const int rt0 = wr * 64 + fr, cl = wc * 32 + 8 * fq; LAS float* xl = xch + rt0 * 4;
        if (tid < 256) xch[2048 + tid] = rinv16(ssq, (size_t)u.pm * BM + tid);
        asm volatile("s_waitcnt lgkmcnt(0)" ::: "memory"); __builtin_amdgcn_s_barrier(); asm volatile("" ::: "memory");
        FOR_AI_M { const int ro = ai * HALF + m * 16; const float r = xch[2048 + rt0 + ro]; float mx = -3.0e38f;
            FOR_BJ {
#pragma unroll
                for (int n = 0; n < 2; ++n) { acc[ai][bj][m][n] *= r; const f32x4 v = acc[ai][bj][m][n]; mx = fmaxf(fmaxf(mx, fmaxf(v[0], v[1])), fmaxf(v[2], v[3])); } }
            mx = fmaxf(mx, __shfl_xor(mx, 16)); mx = fmaxf(mx, __shfl_xor(mx, 32));
            if (fq == 0) xl[ro * 4 + wc] = mx; }
        asm volatile("s_waitcnt lgkmcnt(0)" ::: "memory"); __builtin_amdgcn_s_barrier(); asm volatile("" ::: "memory");
        FOR_AI_M { const int ro = ai * HALF + m * 16; const f32x4 q = *(const LAS f32x4*)(xl + ro * 4); const float M = fmaxf(fmaxf(q[0], q[1]), fmaxf(q[2], q[3])); float s = 0.f;
            FOR_BJ {
#pragma unroll
                for (int n = 0; n < 2; ++n) { f32x4 v = acc[ai][bj][m][n];
#pragma unroll
                    for (int e = 0; e < 4; ++e) { v[e] = fast_exp2(v[e] - M); s += v[e]; }
                    acc[ai][bj][m][n] = v; } }
            s += __shfl_xor(s, 16); s += __shfl_xor(s, 32);
            if (fq == 0) xl[1024 + ro * 4 + wc] = s; }
        asm volatile("s_waitcnt lgkmcnt(0)" ::: "memory"); __builtin_amdgcn_s_barrier(); asm volatile("" ::: "memory");
        char* ob = (char*)O + ((size_t)u.pm * BM * 1024 + (size_t)u.pn * BM) * 2; const unsigned vo = (unsigned)(rt0 * 1024 + cl) * 2u;
        FOR_AI_M { const int ro = ai * HALF + m * 16; const f32x4 q = *(const LAS f32x4*)(xl + 1024 + ro * 4); const float inv = fast_rcp((q[0] + q[1]) + (q[2] + q[3]));
            char* orow = ob + GRP(1024, 2) + vo;
            FOR_BJ *(u32x4*)(orow + bj * 256) = pack8(acc[ai][bj][m][0] * inv, acc[ai][bj][m][1] * inv); }
    }
};
struct EpiMoe1 {
    static constexpr bool PERM = true;
    const float* ssq; LAS float* xch; int tid;
    __device__ __forceinline__ void operator()(EPI_ARGS) const {
        const int rt0 = wr * 64 + fr, cl = wc * 32 + 8 * fq; const unsigned vo = (unsigned)(rt0 * 512 + cl) * 2u;
        if (tid < 256) xch[2048 + tid] = rinv16(ssq, (size_t)((const GAS int*)u.rows)[tid]);
        asm volatile("s_waitcnt lgkmcnt(0)" ::: "memory"); __builtin_amdgcn_s_barrier(); asm volatile("" ::: "memory");
        FOR_AI_M { const float r = xch[2048 + rt0 + ai * HALF + m * 16];
            f32x4 g0 = acc[ai][0][m][0] * r, g1 = acc[ai][0][m][1] * r; const f32x4 u0 = acc[ai][1][m][0] * r, u1 = acc[ai][1][m][1] * r;
#pragma unroll
            for (int e = 0; e < 4; ++e) { g0[e] = g0[e] * sigm(g0[e]) * u0[e]; g1[e] = g1[e] * sigm(g1[e]) * u1[e]; }
            *(u32x4*)(u.C + GRP(512, 2) + vo) = pack8(g0, g1); }
    }
};
struct EpiMoe2 {
    static constexpr bool PERM = true;
    const float* wbuf;
    __device__ __forceinline__ void operator()(EPI_ARGS) const {
        const int rt0 = wr * 64 + fr, cl = wc * 32 + 8 * fq; const unsigned vo = (unsigned)(rt0 * 1024 + cl) * 2u; const char* wb = (const char*)(wbuf + (size_t)u.pm * BM); const unsigned vw = (unsigned)rt0 * 4u;
        FOR_AI_M { const float w = *(const float*)(wb + GRP(1, 4) + vw); char* orow = u.C + GRP(1024, 2) + vo;
            FOR_BJ *(u32x4*)(orow + bj * 256) = pack8(acc[ai][bj][m][0] * w, acc[ai][bj][m][1] * w); }
    }
};

struct SchedFlat {
    const char* A; const char* B; char* C; size_t a_tile, b_tile, b_z, c_row, c_col; int nM, nN, pm_per_z, G, c;
    __device__ __forceinline__ bool next(int i, Unit& u) const {
        const long L = (long)i * G + c; if (L >= (long)nM * nN) return false;
        int pm, pn; tile_of((int)L, nM, nN, pm, pn); u.pm = pm; u.pn = pn; u.z = pm / pm_per_z; u.pad = 0;
        u.A = A + (size_t)pm * a_tile; u.B = B + (size_t)u.z * b_z + (size_t)pn * b_tile; u.C = C + (size_t)pm * c_row + (size_t)pn * c_col; u.rows = nullptr; return true; }
};
struct SchedWqk {
    const char* KVX; const char* WQS; char* WQK; int nz, G, c;
    __device__ __forceinline__ bool next(int i, Unit& u) const {
        const int L = i * G + c; if (L >= nz * 4) return false;
        const int z = L >> 2, pn = L & 3, b = z >> 2, h = z & 3; u.pm = 0; u.pn = pn; u.z = z; u.pad = 0; u.rows = nullptr;
        u.A = KVX + ((size_t)b * 256 * 2048 + h * 256) * 2; u.B = WQS + ((size_t)pn * 256 * 1024 + h * 256) * 2; u.C = WQK + ((size_t)b * 1048576 + (size_t)h * 256 * 1024 + pn * 256) * 2; return true; }
};
struct SchedVwo {
    const char* WOT; const char* KVX; char* VWO; int nz, G, c;
    __device__ __forceinline__ bool next(int i, Unit& u) const {
        const int L = i * G + c; if (L >= nz * 4) return false;
        const int z = L >> 2, pm = L & 3, b = z >> 2, h = z & 3; u.pm = pm; u.pn = 0; u.z = z; u.pad = 0; u.rows = nullptr;
        u.A = WOT + ((size_t)pm * 256 * 1024 + h * 256) * 2; u.B = KVX + ((size_t)b * 256 * 2048 + 1024 + h * 256) * 2; u.C = VWO + ((size_t)b * 1048576 + (size_t)pm * 256 * 1024 + h * 256) * 2; return true; }
};
struct SchedMoe {
    const char* A; const char* Bw; char* C; const int* rowtok; const int* tile_e; const int* ntiles; size_t a_row  , b_e, b_tile, c_row, c_col; int G, cv;
    __device__ __forceinline__ bool next(int i, Unit& u) const {
        const int L = i * G + cv, rt = L >> 2, pn = L & 3;
        const int nt = __builtin_amdgcn_readfirstlane(__hip_atomic_load(ntiles, __ATOMIC_RELAXED, __HIP_MEMORY_SCOPE_AGENT)); if (rt >= nt) return false;
        const int e = __builtin_amdgcn_readfirstlane(__hip_atomic_load(tile_e + rt, __ATOMIC_RELAXED, __HIP_MEMORY_SCOPE_AGENT));
        u.pm = rt; u.pn = pn; u.z = e; u.pad = 0; u.rows = rowtok + (size_t)rt * 256;
        u.A = A + (size_t)rt * 256 * a_row; u.B = Bw + (size_t)e * b_e + (size_t)pn * b_tile; u.C = C + (size_t)rt * 256 * c_row + (size_t)pn * c_col; return true; }
};
struct Params {
    const float* in[27]; float* out; unsigned* ctl;
    bf16_t *WIN_T, *WKV_T, *WA_T, *WB_T, *WOUT_T, *WQS, *WO_T, *WR_T, *WGU_T, *WD_T, *WSP;
    bf16_t *XN, *MN, *KVX, *Q, *K, *V, *ZU, *ZV, *GA, *GB, *OG, *YA, *YB, *M1, *MERGED, *H1, *PX, *H2, *WQK, *VWO, *HB, *YBX;
    float *ROPE, *LSE, *SSQ1, *SSQ2, *WGT, *WBUF;
    int *EID, *BCNT, *TOT, *ROWTOK, *POSOF, *TILE_E;
    int nb, T, b0, ph_lo, ph_hi, pad;
};
struct Ctx { LAS unsigned char* lds; int tid, lane, wave, vcu, G, gw, ngw; };
#define LDS_WAIT() asm volatile("s_waitcnt lgkmcnt(0)" ::: "memory")
#define VM_WAIT() asm volatile("s_waitcnt vmcnt(0)" ::: "memory")
__device__ __forceinline__ float wave_sum(float v) {
#pragma unroll
    for (int o = 1; o < 64; o <<= 1) v += __shfl_xor(v, o);
    return v;
}
typedef short v4i16_t __attribute__((ext_vector_type(4)));
__device__ __forceinline__ s16x4 tr_read(LAS unsigned char* p) { return __builtin_bit_cast(s16x4, __builtin_amdgcn_ds_read_tr16_b64_v4i16((LAS v4i16_t*)p)); }

__device__ __forceinline__ int rowmap(int mode, int n) {
    if (mode == 1) { if (n < 1536) { const int d = n & 63; return (n & ~63) + 2 * (d & 31) + (d >> 5); } return n; }
    if (mode == 2) return (n >> 7) * 256 + (n & 127);
    if (mode == 3) return (n >> 7) * 256 + 128 + (n & 127);
    return n;
}
__device__ __forceinline__ void tr_item(const float* W, int ldw, int K, bf16_t* WT, const float* kscale, int mode, int kb, int nbk, int lane) {
    const int k0 = 64 * kb, n0 = 64 * nbk;
    const float* src = W + (size_t)k0 * ldw + n0 + lane;
    float v[64];
#pragma unroll
    for (int i = 0; i < 64; ++i) v[i] = src[(size_t)i * ldw];
    if (kscale) { const float ks = kscale[k0 + lane];
#pragma unroll
        for (int i = 0; i < 64; ++i) v[i] *= __builtin_bit_cast(float, __builtin_amdgcn_readlane(__builtin_bit_cast(int, ks), i)); }
    u32x4* dst = (u32x4*)(WT + (size_t)rowmap(mode, n0 + lane) * K + k0);
#pragma unroll
    for (int c = 0; c < 8; ++c) { u32x4 o; o.x = cvt_pk_bf16(v[8 * c], v[8 * c + 1]); o.y = cvt_pk_bf16(v[8 * c + 2], v[8 * c + 3]); o.z = cvt_pk_bf16(v[8 * c + 4], v[8 * c + 5]); o.w = cvt_pk_bf16(v[8 * c + 6], v[8 * c + 7]); dst[c] = o; }
}
__device__ __forceinline__ void rms_row_bf16(const float* xrow, const float* g, bf16_t* orow, int lane) {
    const f32x4* xr = (const f32x4*)xrow + lane; const f32x4* gr = (const f32x4*)g + lane;
    f32x4 v[4]; float s = 0.f;
#pragma unroll
    for (int j = 0; j < 4; ++j) { v[j] = xr[64 * j]; s += (v[j][0] * v[j][0] + v[j][1] * v[j][1]) + (v[j][2] * v[j][2] + v[j][3] * v[j][3]); }
    const float r = rsqrtf(wave_sum(s) * (1.0f / 1024.0f) + 1e-6f);
    u32x2* o8 = (u32x2*)orow + lane;
#pragma unroll
    for (int j = 0; j < 4; ++j) { const f32x4 gg = gr[64 * j]; u32x2 w; w.x = cvt_pk_bf16(v[j][0] * r * gg[0], v[j][1] * r * gg[1]); w.y = cvt_pk_bf16(v[j][2] * r * gg[2], v[j][3] * r * gg[3]); o8[64 * j] = w; }
}
__device__ __forceinline__ void p0_prologue(const Params& P, const Ctx& X) {
    const float *w_in = P.in[4], *w_oa = P.in[10], *w_ob = P.in[11], *w_out = P.in[12], *xg = P.in[13], *w_q = P.in[15], *w_kv = P.in[16], *w_o = P.in[17], *moe_g = P.in[18],
                *w_rg = P.in[19], *w_re = P.in[21], *w_ge = P.in[23], *w_ue = P.in[24], *w_de = P.in[25], *w_sp = P.in[6];
    constexpr int I_IN = 16 * 84, I_KV = 16 * 32, I_A = 4 * 16, I_B = 8 * 16, I_OUT = 16 * 16, I_O = 16 * 16, I_G = 16 * 8 * 32, I_U = I_G, I_D = 8 * 16 * 32;
    constexpr int NITEMS = I_IN + I_KV + I_A + I_B + I_OUT + I_O + I_G + I_U + I_D;
    for (int it = X.gw; it < NITEMS; it += X.ngw) {
        int r = it;
        if (r < I_IN) { tr_item(w_in, 5376, 1024, P.WIN_T, nullptr, 1, r / 84, r % 84, X.lane); continue; } r -= I_IN;
        if (r < I_KV) { tr_item(w_kv, 2048, 1024, P.WKV_T, nullptr, 0, r / 32, r % 32, X.lane); continue; } r -= I_KV;
        if (r < I_A) { tr_item(w_oa, 1024, 256, P.WA_T, nullptr, 0, r / 16, r % 16, X.lane); continue; } r -= I_A;
        if (r < I_B) { tr_item(w_ob, 1024, 512, P.WB_T, nullptr, 0, r / 16, r % 16, X.lane); continue; } r -= I_B;
        if (r < I_OUT) { tr_item(w_out, 1024, 1024, P.WOUT_T, nullptr, 0, r / 16, r % 16, X.lane); continue; } r -= I_OUT;
        if (r < I_O) { tr_item(w_o, 1024, 1024, P.WO_T, nullptr, 0, r / 16, r % 16, X.lane); continue; } r -= I_O;
        if (r < I_G) { const int e = r >> 7, q = r & 127; tr_item(w_ge + (size_t)e * 524288, 512, 1024, P.WGU_T + (size_t)e * 1048576, moe_g, 2, q >> 3, q & 7, X.lane); continue; } r -= I_G;
        if (r < I_U) { const int e = r >> 7, q = r & 127; tr_item(w_ue + (size_t)e * 524288, 512, 1024, P.WGU_T + (size_t)e * 1048576, moe_g, 3, q >> 3, q & 7, X.lane); continue; } r -= I_U;
        { const int e = r >> 7, q = r & 127; tr_item(w_de + (size_t)e * 524288, 1024, 512, P.WD_T + (size_t)e * 524288, nullptr, 0, q >> 4, q & 15, X.lane); }
    }
    const int gt = X.gw * 64 + X.lane, ngt = X.ngw * 64;
    for (int i = gt; i < 1024 * 128; i += ngt) { const int row = i >> 7; const float g = xg[row]; const f32x4 a = *(const f32x4*)(w_q + (size_t)i * 8) * g, b = *(const f32x4*)(w_q + (size_t)i * 8 + 4) * g; *(u32x4*)(P.WQS + (size_t)i * 8) = pack8(a, b); }
    for (int i = gt; i < 48 * 1024; i += ngt) { const int row = i >> 10, k = i & 1023; float v = 0.f; if (row < 4) v = w_rg[k * 4 + row]; else if (row < 36) v = w_re[k * 32 + row - 4];
        P.WR_T[i] = (bf16_t)(cvt_pk_bf16(v * moe_g[k], 0.f) & 0xffffu); }
    for (int i = gt; i < 4 * 128 * 128; i += ngt) { const int s = i & 127, t = (i >> 7) & 127; P.WSP[i] = (bf16_t)(cvt_pk_bf16(s <= t ? w_sp[i] : 0.f, 0.f) & 0xffffu); }
    { const int* pos = (const int*)P.in[2] + (size_t)P.b0 * 4096;
      for (int i = gt; i < P.T * 32; i += ngt) { const int t = i >> 5, f = i & 31; const float ang = (float)pos[t] * powf(10000.0f, -(float)f / 32.0f); P.ROPE[(size_t)t * 64 + f] = cosf(ang); P.ROPE[(size_t)t * 64 + 32 + f] = sinf(ang); } }
    { const float* x = P.in[0] + (size_t)P.b0 * 4096 * 1024; const float* mem = P.in[1] + (size_t)P.b0 * 256 * 1024;
      for (int m = X.gw; m < P.T; m += X.ngw) rms_row_bf16(x + (size_t)m * 1024, P.in[3], P.XN + (size_t)m * 1024, X.lane);
      for (int m = X.gw; m < P.nb * 256; m += X.ngw) rms_row_bf16(mem + (size_t)m * 1024, P.in[14], P.MN + (size_t)m * 1024, X.lane); }
}

__device__ __forceinline__ void attn_phase(const Params& P, const Ctx& X) {
    LAS unsigned char* Ks = X.lds; LAS unsigned char* Vs = X.lds + 32768;
    const int lane = X.lane, w = X.wave, fr = lane & 15, fq = lane >> 4;
    const int nunits = P.nb * 384;
    const int srow = X.tid >> 3, sch = X.tid & 7;
    const unsigned ldsk = (unsigned)(srow * 128 + ((sch ^ ((srow >> 1) & 7)) << 4)), ldsv = (unsigned)(srow * 128 + ((sch ^ (srow & 7)) << 4));
    for (int U = X.vcu; U < nunits; U += X.G) {
        const int b = U / 384, rem = U - b * 384, head = rem >> 5, blk = rem & 31, g = head >> 2, j = head & 3;
        const int dsh = 2 * g, dil = 1 << dsh, nbk = 32 >> dsh, r = blk / nbk, n = blk - r * nbk;
        const long ebase = ((long)b * 4096 + (long)(n - 1) * 128 * dil + r) * 768 + head * 64;
        const unsigned vsrc = (unsigned)(srow * dil * 768 + sch * 8) * 2u; const size_t pstride = (size_t)64 * dil * 768 * 2;
        const char* kb = (const char*)P.K + ebase * 2; const char* vb = (const char*)P.V + ebase * 2;
        u32x4 kreg[4], vreg[4];
#pragma unroll
        for (int p = 0; p < 4; ++p) {
            if (p >= 2 || n > 0) { kreg[p] = *(const u32x4*)(kb + p * pstride + vsrc); vreg[p] = *(const u32x4*)(vb + p * pstride + vsrc); }
            else { kreg[p] = (u32x4){0u, 0u, 0u, 0u}; vreg[p] = (u32x4){0u, 0u, 0u, 0u}; } }
        const unsigned vq = (unsigned)((128 + 16 * w + fr) * dil * 768 + 8 * fq) * 2u;
        const bf16x8 q0 = *(const bf16x8*)((const char*)P.Q + ebase * 2 + vq), q1 = *(const bf16x8*)((const char*)P.Q + ebase * 2 + 64 + vq);
        __syncthreads();
#pragma unroll
        for (int p = 0; p < 4; ++p) { *(LAS u32x4*)(Ks + p * 8192 + ldsk) = kreg[p]; *(LAS u32x4*)(Vs + p * 8192 + ldsv) = vreg[p]; }
        __syncthreads();
        const int s0 = w < 6 ? w : 6;
        f32x4 sc[10];
        { const int row0 = 16 * s0 + fr; const int sw = (row0 >> 1) & 7;
          LAS unsigned char* kp0 = Ks + row0 * 128 + ((fq ^ sw) << 4); LAS unsigned char* kp1 = Ks + row0 * 128 + (((4 + fq) ^ sw) << 4);
#pragma unroll
          for (int st = 0; st < 10; ++st) { const bf16x8 k0 = *(const LAS bf16x8*)(kp0 + st * 2048), k1 = *(const LAS bf16x8*)(kp1 + st * 2048);
            f32x4 a = {0.f, 0.f, 0.f, 0.f}; a = __builtin_amdgcn_mfma_f32_16x16x32_bf16(k0, q0, a, 0, 0, 0); a = __builtin_amdgcn_mfma_f32_16x16x32_bf16(k1, q1, a, 0, 0, 0); sc[st] = a; } }
        const int qi = 16 * w + fr, kc0 = 16 * s0 + 4 * fq - qi, klo = n > 0 ? 0 : 128 - qi; float mx = -3.0e38f;
#pragma unroll
        for (int st = 0; st < 10; ++st)
#pragma unroll
            for (int e = 0; e < 4; ++e) { const int dk = kc0 + 16 * st + e; const bool ok = (dk >= 0) && (dk <= 128) && (dk >= klo); sc[st][e] = ok ? sc[st][e] : -3.0e38f; mx = fmaxf(mx, sc[st][e]); }
        mx = fmaxf(mx, __shfl_xor(mx, 16)); mx = fmaxf(mx, __shfl_xor(mx, 32));
        float l = 0.f;
#pragma unroll
        for (int st = 0; st < 10; ++st)
#pragma unroll
            for (int e = 0; e < 4; ++e) { const float pe = sc[st][e] > -1.0e38f ? fast_exp2(sc[st][e] - mx) : 0.f; sc[st][e] = pe; l += pe; }
        l += __shfl_xor(l, 16); l += __shfl_xor(l, 32);
        f32x4 o[4];
#pragma unroll
        for (int dt = 0; dt < 4; ++dt) o[dt] = (f32x4){0.f, 0.f, 0.f, 0.f};
        { const int krow = 16 * s0 + 4 * fq + (fr >> 2), ksw = krow & 7;
          const int by = (fr & 1) * 8, chl = (fr & 3) >> 1;
#pragma unroll
          for (int kk = 0; kk < 5; ++kk) {
            bf16x8 pb; { const unsigned w0 = cvt_pk_bf16(sc[2 * kk][0], sc[2 * kk][1]), w1 = cvt_pk_bf16(sc[2 * kk][2], sc[2 * kk][3]), w2 = cvt_pk_bf16(sc[2 * kk + 1][0], sc[2 * kk + 1][1]), w3 = cvt_pk_bf16(sc[2 * kk + 1][2], sc[2 * kk + 1][3]);
                pb = __builtin_bit_cast(bf16x8, (u32x4){w0, w1, w2, w3}); }
#pragma unroll
            for (int dt = 0; dt < 4; ++dt) { LAS unsigned char* vp = Vs + krow * 128 + (((2 * dt + chl) ^ ksw) << 4) + by + kk * 4096;
                const s16x4 lo = tr_read(vp), hi = tr_read(vp + 2048);
                const bf16x8 va = {lo[0], lo[1], lo[2], lo[3], hi[0], hi[1], hi[2], hi[3]};
                o[dt] = __builtin_amdgcn_mfma_f32_16x16x32_bf16(va, pb, o[dt], 0, 0, 0); }
          } }
        const float inv = fast_rcp(l); const long qtok = (long)b * 4096 + ((long)n * 128 + 16 * w + fr) * dil + r;
        bf16_t* og = P.OG + ((size_t)g * P.T + qtok) * 256 + j * 64 + 4 * fq;
#pragma unroll
        for (int dt = 0; dt < 4; ++dt) { u32x2 wv; wv.x = cvt_pk_bf16(o[dt][0] * inv, o[dt][1] * inv); wv.y = cvt_pk_bf16(o[dt][2] * inv, o[dt][3] * inv); *(u32x2*)(og + 16 * dt) = wv; }
        if (fq == 0) P.LSE[((size_t)g * P.T + qtok) * 4 + j] = mx + __builtin_amdgcn_logf(l);
    }
    __syncthreads();
}
__device__ __forceinline__ void merge_phase(const Params& P, const Ctx& X) {
    const int gt = X.gw * 64 + X.lane, ngt = X.ngw * 64; const size_t T = (size_t)P.T;
    for (int i = gt; i < P.T * 32; i += ngt) { const size_t t = (size_t)(i >> 5); const int c8 = i & 31, j = c8 >> 3;
        const float l0 = P.LSE[t * 4 + j], l1 = P.LSE[(T + t) * 4 + j], l2 = P.LSE[(2 * T + t) * 4 + j]; const float M = fmaxf(l0, fmaxf(l1, l2));
        const float e0 = fast_exp2(l0 - M), e1 = fast_exp2(l1 - M), e2 = fast_exp2(l2 - M), inv = fast_rcp(e0 + e1 + e2);
        f32x4 a0, b0, a1, b1, a2, b2; unpack8(*(const u32x4*)(P.OG + t * 256 + c8 * 8), a0, b0); unpack8(*(const u32x4*)(P.OG + (T + t) * 256 + c8 * 8), a1, b1); unpack8(*(const u32x4*)(P.OG + (2 * T + t) * 256 + c8 * 8), a2, b2);
        *(u32x4*)(P.YA + t * 256 + c8 * 8) = pack8((a0 * e0 + a1 * e1 + a2 * e2) * inv, (b0 * e0 + b1 * e1 + b2 * e2) * inv); }
}
__device__ __forceinline__ int gsw(int row) { return ((row & 3) | (((row >> 3) & 1) << 2)) << 1; }
__device__ __forceinline__ void gmlp_phase(const Params& P, const Ctx& X) {
    LAS unsigned char* VL = X.lds; const int lane = X.lane, w = X.wave, fr = lane & 15, fq = lane >> 4;
    const float* vg = P.in[8]; const float* vb = P.in[9]; const float* bsp = P.in[7];
    const int nch = P.T / 128;
    for (int ch = X.vcu; ch < nch; ch += X.G) {
        const size_t t0 = (size_t)ch * 128;
        __syncthreads();
        { const f32x4 g0 = *(const f32x4*)(vg + 8 * lane), g1 = *(const f32x4*)(vg + 8 * lane + 4), b0 = *(const f32x4*)(vb + 8 * lane), b1 = *(const f32x4*)(vb + 8 * lane + 4);
          const char* zb = (const char*)(P.ZV + (t0 + 16 * w) * 512) + 16 * lane;
#pragma unroll 4
          for (int i = 0; i < 16; ++i) { const int s = 16 * w + i; f32x4 a, b; unpack8(*(const u32x4*)(zb + i * 1024), a, b);
            const float mean = wave_sum((a[0] + a[1]) + (a[2] + a[3]) + (b[0] + b[1]) + (b[2] + b[3])) * (1.0f / 512.0f); a -= mean; b -= mean;
            const float rstd = rsqrtf(wave_sum((a[0] * a[0] + a[1] * a[1]) + (a[2] * a[2] + a[3] * a[3]) + (b[0] * b[0] + b[1] * b[1]) + (b[2] * b[2] + b[3] * b[3])) * (1.0f / 512.0f) + 1e-5f);
            *(LAS u32x4*)(VL + s * 1024 + ((lane ^ gsw(s)) << 4)) = pack8(a * rstd * g0 + b0, b * rstd * g1 + b1); } }
        __syncthreads();
        const int gch = w >> 1; const char* wsp = (const char*)(P.WSP + (size_t)gch * 16384) + (unsigned)(fr * 128 + 8 * fq) * 2u;
        const int by = (fr & 1) * 8, chl = (fr & 3) >> 1, sr0 = 8 * fq + (fr >> 2);
        const char* zu = (const char*)(P.ZU + t0 * 512); char* yb = (char*)(P.YB + t0 * 512); const unsigned vo = (unsigned)(fr * 512 + 64 * w + 4 * fq) * 2u; const float* bsg = bsp + gch * 128 + fr;
#pragma unroll
        for (int th = 0; th < 2; ++th) {
            f32x4 acc[4][4];
#pragma unroll
            for (int ct = 0; ct < 4; ++ct)
#pragma unroll
                for (int tq = 0; tq < 4; ++tq) acc[ct][tq] = (f32x4){0.f, 0.f, 0.f, 0.f};
#pragma unroll
            for (int ks = 0; ks < 4; ++ks) { if (32 * ks > 64 * th + 63) continue;
                const int srow = 32 * ks + sr0;
                bf16x8 va[4];
#pragma unroll
                for (int ct = 0; ct < 4; ++ct) { const int chn = 8 * w + 2 * ct + chl;
                    const s16x4 lo = tr_read(VL + srow * 1024 + ((chn ^ gsw(srow)) << 4) + by), hi = tr_read(VL + (srow + 4) * 1024 + ((chn ^ gsw(srow + 4)) << 4) + by);
                    va[ct] = (bf16x8){lo[0], lo[1], lo[2], lo[3], hi[0], hi[1], hi[2], hi[3]}; }
#pragma unroll
                for (int tq = 0; tq < 4; ++tq) { const int tt = 4 * th + tq; if (32 * ks > 16 * tt + 15) continue;
                    const bf16x8 wb = *(const bf16x8*)(wsp + tt * 4096 + ks * 64);
#pragma unroll
                    for (int ct = 0; ct < 4; ++ct) acc[ct][tq] = __builtin_amdgcn_mfma_f32_16x16x32_bf16(va[ct], wb, acc[ct][tq], 0, 0, 0); }
            }
#pragma unroll
            for (int tq = 0; tq < 4; ++tq) { const int tt = 4 * th + tq; const float bs = bsg[16 * tt];
#pragma unroll
                for (int ct = 0; ct < 4; ++ct) { const size_t off = (size_t)tt * 16384 + ct * 32; const u32x2 uu = *(const u32x2*)(zu + off + vo); const f32x4 a = acc[ct][tq] + bs;
                    u32x2 o; o.x = cvt_pk_bf16(bf_lo(uu.x) * a[0], bf_hi(uu.x) * a[1]); o.y = cvt_pk_bf16(bf_lo(uu.y) * a[2], bf_hi(uu.y) * a[3]); *(u32x2*)(yb + off + vo) = o; } }
        }
    }
    __syncthreads();
}
__device__ __forceinline__ void router_phase(const Params& P, const Ctx& X) {
    LAS unsigned char* WR = X.lds; LAS float* LG = (LAS float*)(X.lds + 98304) + X.wave * 1536; LAS int* CNT = (LAS int*)(X.lds + 98304 + 49152);
    const int lane = X.lane, w = X.wave, fr = lane & 15, fq = lane >> 4;
    for (int i = X.tid; i < 48 * 128; i += 512) { const int row = i >> 7, chk = i & 127; *(LAS u32x4*)(WR + row * 2048 + ((chk ^ (row & 15)) << 4)) = *(const u32x4*)(P.WR_T + (size_t)i * 8); }
    const float* bg = P.in[20]; const float* be = P.in[22];
    const int ntb = P.T / 256;
    for (int tbk = X.vcu; tbk < ntb; tbk += X.G) {
        if (X.tid < 32) CNT[X.tid] = 0;
        __syncthreads();
        f32x4 acc[2][3];
#pragma unroll
        for (int a = 0; a < 2; ++a)
#pragma unroll
            for (int c = 0; c < 3; ++c) acc[a][c] = (f32x4){0.f, 0.f, 0.f, 0.f};
        const bf16_t* hrow = P.H2 + ((size_t)tbk * 256 + 32 * w + fr) * 1024 + 8 * fq;
#pragma unroll 4
        for (int ks = 0; ks < 32; ++ks) {
            const bf16x8 a0 = *(const bf16x8*)(hrow + 32 * ks), a1 = *(const bf16x8*)(hrow + 16 * 1024 + 32 * ks);
#pragma unroll
            for (int c = 0; c < 3; ++c) { const int row = 16 * c + fr; const bf16x8 bw = *(const LAS bf16x8*)(WR + row * 2048 + (((4 * ks + fq) ^ (row & 15)) << 4));
                acc[0][c] = __builtin_amdgcn_mfma_f32_16x16x32_bf16(a0, bw, acc[0][c], 0, 0, 0); acc[1][c] = __builtin_amdgcn_mfma_f32_16x16x32_bf16(a1, bw, acc[1][c], 0, 0, 0); }
        }
#pragma unroll
        for (int a = 0; a < 2; ++a)
#pragma unroll
            for (int c = 0; c < 3; ++c)
#pragma unroll
                for (int e = 0; e < 4; ++e) LG[(16 * a + 4 * fq + e) * 48 + 16 * c + fr] = acc[a][c][e];
        LDS_WAIT(); asm volatile("" ::: "memory");
        if (lane < 32) {
            const int t = tbk * 256 + 32 * w + lane; const float r = rinv16(P.SSQ2, (size_t)t); const LAS float* lg = LG + lane * 48;
            float g4[4]; int grp = 0; float gm = -3.0e38f;
#pragma unroll
            for (int c = 0; c < 4; ++c) { g4[c] = lg[c] * r + bg[c]; if (g4[c] > gm) { gm = g4[c]; grp = c; } }
            float den = 0.f;
#pragma unroll
            for (int c = 0; c < 4; ++c) den += __expf(g4[c] - gm);
            float v0 = -3.0e38f, v1 = -3.0e38f; int i0 = 0, i1 = 0;
#pragma unroll
            for (int i = 0; i < 8; ++i) { const float v = lg[4 + grp * 8 + i] * r + be[grp * 8 + i]; if (v > v0) { v1 = v0; i1 = i0; v0 = v; i0 = i; } else if (v > v1) { v1 = v; i1 = i; } }
            const float e1 = __expf(v1 - v0), gg = 1.0f / den, p0 = gg / (1.0f + e1), p1 = gg * e1 / (1.0f + e1);
            P.EID[2 * t] = grp * 8 + i0; P.EID[2 * t + 1] = grp * 8 + i1; P.WGT[2 * t] = p0; P.WGT[2 * t + 1] = p1;
            __hip_atomic_fetch_add(&CNT[grp * 8 + i0], 1, __ATOMIC_RELAXED, __HIP_MEMORY_SCOPE_WORKGROUP); __hip_atomic_fetch_add(&CNT[grp * 8 + i1], 1, __ATOMIC_RELAXED, __HIP_MEMORY_SCOPE_WORKGROUP);
        }
        __syncthreads();
        if (X.tid < 32) P.BCNT[tbk * 32 + X.tid] = CNT[X.tid];
        __syncthreads();
    }
}
__device__ __forceinline__ void positions_phase(const Params& P, const Ctx& X) {
    LAS int* TOT = (LAS int*)X.lds; LAS int* BEF = TOT + 32; LAS int* PST = TOT + 64; LAS int* EL = TOT + 128;
    const int ntb = P.T / 256;
    for (int tbk = X.vcu; tbk < ntb; tbk += X.G) {
        __syncthreads();
        if (X.tid < 32) { int tot = 0, bef = 0; for (int q = 0; q < ntb; ++q) { const int c = P.BCNT[q * 32 + X.tid]; tot += c; if (q < tbk) bef += c; } TOT[X.tid] = tot; BEF[X.tid] = bef; }
        EL[X.tid] = P.EID[(size_t)tbk * 512 + X.tid];
        __syncthreads();
        if (X.tid == 0) { int s = 0; for (int e = 0; e < 32; ++e) { PST[e] = s; s += (TOT[e] + 255) & ~255; } PST[32] = s; }
        __syncthreads();
        { const int a = X.tid, e = EL[a]; int rank = 0; for (int q = 0; q < a; ++q) rank += (EL[q] == e) ? 1 : 0;
          const int pos = PST[e] + BEF[e] + rank; const size_t ga = (size_t)tbk * 512 + a;
          P.ROWTOK[pos] = (int)(ga >> 1); P.WBUF[pos] = P.WGT[ga]; P.POSOF[ga] = pos; }
        if (tbk == 0) { for (int e = 0; e < 32; ++e) for (int q = PST[e] + TOT[e] + X.tid; q < PST[e + 1]; q += 512) { P.ROWTOK[q] = 0; P.WBUF[q] = 0.f; } }
        if (tbk == 0) { const int nt = PST[32] >> 8; for (int rt = X.tid; rt < nt; rt += 512) { int e = 0; while (PST[e + 1] <= rt * 256) ++e; P.TILE_E[rt] = e; } if (X.tid == 0) P.TILE_E[1024] = nt; }
    }
    __syncthreads();
}
__device__ __forceinline__ void final_phase(const Params& P, const Ctx& X) {
    const float* g = P.in[26]; const int lane = X.lane;
    for (int t = X.gw; t < P.T; t += X.ngw) {
        const int p0 = P.POSOF[2 * (size_t)t], p1 = P.POSOF[2 * (size_t)t + 1];
        const bf16_t* h = P.H2 + (size_t)t * 1024; const bf16_t* y0 = P.YBX + (size_t)p0 * 1024; const bf16_t* y1 = P.YBX + (size_t)p1 * 1024;
        f32x4 v[4]; float s = 0.f;
#pragma unroll
        for (int q = 0; q < 2; ++q) { f32x4 a, b, c, d, e, f; unpack8(*(const u32x4*)(h + 512 * q + 8 * lane), a, b); unpack8(*(const u32x4*)(y0 + 512 * q + 8 * lane), c, d); unpack8(*(const u32x4*)(y1 + 512 * q + 8 * lane), e, f);
            v[2 * q] = a + c + e; v[2 * q + 1] = b + d + f; }
#pragma unroll
        for (int q = 0; q < 4; ++q) s += (v[q][0] * v[q][0] + v[q][1] * v[q][1]) + (v[q][2] * v[q][2] + v[q][3] * v[q][3]);
        const float r = rsqrtf(wave_sum(s) * (1.0f / 1024.0f) + 1e-6f);
        float* o = P.out + (size_t)t * 1024;
#pragma unroll
        for (int q = 0; q < 2; ++q) { const f32x4 ga = *(const f32x4*)(g + 512 * q + 8 * lane), gb = *(const f32x4*)(g + 512 * q + 8 * lane + 4);
            *(f32x4*)(o + 512 * q + 8 * lane) = v[2 * q] * r * ga; *(f32x4*)(o + 512 * q + 8 * lane + 4) = v[2 * q + 1] * r * gb; }
    }
}
#define XB_TMO      128
#define XB_XCNT(j)  (256  + 64 * (j))
#define XB_XSUB(j)  (1280 + 64 * (j))
#define XB_XGEN(j)  (2304 + 64 * (j))
#define XB_TOP      3328
#define XB_TOPGEN   3392
#define XCD_BAR_WORDS 3456
#define XB_SPIN_CAP (1u << 22)
__device__ __forceinline__ unsigned xb_ld(unsigned* p)              { return __hip_atomic_load(p, __ATOMIC_RELAXED, __HIP_MEMORY_SCOPE_AGENT); }
__device__ __forceinline__ unsigned xb_add(unsigned* p, unsigned v) { return __hip_atomic_fetch_add(p, v, __ATOMIC_RELAXED, __HIP_MEMORY_SCOPE_AGENT); }
__device__ __forceinline__ unsigned xb_xcc_id() { return (unsigned)__builtin_amdgcn_s_getreg((3 << 11) | 20) & 0xFu; }
#define XB_SPIN(cond, bar) do { unsigned _sp = 0; while (cond) { __builtin_amdgcn_s_sleep(1); \
    if ((++_sp & 255u) == 0u) { if (xb_ld(&(bar)[XB_TMO])) break; if (_sp > XB_SPIN_CAP) { atomicAdd(&(bar)[XB_TMO], 1u); break; } } } } while (0)
struct XcdBarrier { unsigned* bar; unsigned x; volatile LAS unsigned* st; };
__device__ __forceinline__ XcdBarrier xcd_barrier_post(unsigned* bar, volatile LAS unsigned* st) {
    XcdBarrier b; b.bar = bar; b.x = xb_xcc_id(); b.st = st;
    if (threadIdx.x == 0) (void)xb_add(&bar[XB_XCNT(b.x)], 1u);
    return b;
}
__device__ __forceinline__ void xcd_barrier_complete(unsigned* bar, unsigned x, unsigned& nloc, unsigned& nx) {
    const unsigned G = gridDim.x * gridDim.y * gridDim.z;
    unsigned sum, cnt, mine, sp = 0u;
    for (;;) {
        sum = 0u; cnt = 0u; mine = 0u;
#pragma unroll
        for (unsigned j = 0; j < 16; ++j) { const unsigned c = xb_ld(&bar[XB_XCNT(j)]); sum += c; cnt += (c > 0u) ? 1u : 0u; mine = (j == x) ? c : mine; }
        if (sum == G) break;
        __builtin_amdgcn_s_sleep(1);
        if ((++sp & 255u) == 0u) { if (xb_ld(&bar[XB_TMO])) break; if (sp > XB_SPIN_CAP) { atomicAdd(&bar[XB_TMO], 1u); break; } }
    }
    nloc = mine > 0u ? mine : 1u; nx = cnt > 0u ? cnt : 1u;
}
__device__ __forceinline__ void xcd_barrier(const XcdBarrier& b) {
    asm volatile("s_waitcnt vmcnt(0)" ::: "memory");
    __syncthreads();
    if (threadIdx.x == 0) {
        unsigned* bar = b.bar;
        __builtin_amdgcn_s_waitcnt(0);
        unsigned nloc = b.st[0], nx = b.st[1];
        if (nloc == 0u) { xcd_barrier_complete(bar, b.x, nloc, nx); b.st[0] = nloc; b.st[1] = nx; }
        const unsigned old = xb_add(&bar[XB_XSUB(b.x)], 1u);
        const unsigned gen = old / nloc;
        if (old + 1u == (gen + 1u) * nloc) {
            __builtin_amdgcn_fence(__ATOMIC_RELEASE, "agent");
            asm volatile("s_waitcnt vmcnt(0)" ::: "memory");
            const unsigned og = xb_add(&bar[XB_TOP], 1u);
            const unsigned tg = og / nx;
            if (og + 1u == (tg + 1u) * nx) xb_add(&bar[XB_TOPGEN], 1u);
            else XB_SPIN(xb_ld(&bar[XB_TOPGEN]) == tg, bar);
            __builtin_amdgcn_fence(__ATOMIC_ACQUIRE, "agent");
            xb_add(&bar[XB_XGEN(b.x)], 1u);
            asm volatile("s_waitcnt vmcnt(0)" ::: "memory");
        } else {
            XB_SPIN(xb_ld(&bar[XB_XGEN(b.x)]) == gen, bar);
            __builtin_amdgcn_fence(__ATOMIC_ACQUIRE, "agent");
            asm volatile("s_waitcnt vmcnt(0)" ::: "memory");
        }
    }
    __syncthreads();
}

constexpr int LDS_BYTES = 163840, XCH_OFF = 131072, MISC_OFF = 163840 - 256;
constexpr int NPHASE = 14;
constexpr int CW_BAR = 4096;
#define CAS __attribute__((address_space(4)))
__global__ void __launch_bounds__(512, 2) mk_fwd(Params P_unused) {
    const CAS Params* kp = (const CAS Params*)__builtin_amdgcn_kernarg_segment_ptr();
#if defined(__HIP_DEVICE_COMPILE__)
#define PLOAD const Params P = *kp
#else
#define PLOAD const Params P = P_unused; (void)kp
#endif
    extern __shared__ __attribute__((aligned(16))) unsigned char lds_raw[];
    Ctx X; X.lds = (LAS unsigned char*)lds_raw; X.tid = threadIdx.x; X.lane = X.tid & 63; X.wave = __builtin_amdgcn_readfirstlane(X.tid >> 6);
    X.G = gridDim.x; { const int bx = blockIdx.x; X.vcu = (X.G % 8 == 0) ? (bx % 8) * (X.G / 8) + bx / 8 : bx; }
    X.gw = X.vcu * 8 + X.wave; X.ngw = X.G * 8;
    volatile LAS unsigned* MISC = (volatile LAS unsigned*)(X.lds + MISC_OFF);
    if (X.tid < 64) MISC[X.tid] = 0u;
    __syncthreads();
    const int lo = kp->ph_lo, hi = kp->ph_hi;
    XcdBarrier bar; bar.bar = kp->ctl + CW_BAR; bar.x = 0; bar.st = nullptr;
    if (hi - lo > 1) bar = xcd_barrier_post(kp->ctl + CW_BAR, MISC + 8);
#ifndef PHASE_MASK
#define PHASE_MASK 0x3fff
#endif
#define IN(k) (((PHASE_MASK >> (k)) & 1) && lo <= (k) && (k) < hi)
#define SEAM(k) do { if (IN(k) && IN((k) + 1)) xcd_barrier(bar); } while (0)
    const int nM = kp->T / 256, c = (int)blockIdx.x, G = X.G;
    LAS unsigned char* ring = X.lds;

    if (IN(0)) { PLOAD; p0_prologue(P, X); }
    SEAM(0);
    if (IN(1)) { PLOAD;
        { SchedFlat S{(const char*)P.XN, (const char*)P.WIN_T, nullptr, (size_t)256 * 1024 * 2, (size_t)256 * 1024 * 2, 0, 0, 0, nM, 21, 1 << 30, G, c};
          EpiProj E{(unsigned char*)P.Q, (size_t)P.T * 16, P.ROPE, P.in[5]};
          gemm_phase<EpiProj, SchedFlat>(ring, 1024, 1024, 1024, S, E); }
        { SchedFlat S{(const char*)P.MN, (const char*)P.WKV_T, (char*)P.KVX, (size_t)256 * 1024 * 2, (size_t)256 * 1024 * 2, 0, (size_t)256 * 2048 * 2, (size_t)256 * 2, P.nb, 8, 1 << 30, G, c};
          EpiPlain E{2048, 1.0f};
          gemm_phase<EpiPlain, SchedFlat>(ring, 1024, 1024, 1024, S, E); }
    }
    SEAM(1);
    if (IN(2)) { PLOAD;
#ifndef P2_PARTS
#define P2_PARTS 7
#endif
        if (P2_PARTS & 1) attn_phase(P, X);
        if (P2_PARTS & 2) gmlp_phase(P, X);
        if (P2_PARTS & 4) { SchedWqk S{(const char*)P.KVX, (const char*)P.WQS, (char*)P.WQK, P.nb * 4, G, c}; EpiPlain E{1024, XSCALE}; gemm_phase<EpiPlain, SchedWqk>(ring, 256, 2048, 1024, S, E); }
        if (P2_PARTS & 4) { SchedVwo S{(const char*)P.WO_T, (const char*)P.KVX, (char*)P.VWO, P.nb * 4, G, c}; EpiPlain E{1024, 1.0f}; gemm_phase<EpiPlain, SchedVwo>(ring, 256, 1024, 2048, S, E); }
    }
    SEAM(2);
    if (IN(3)) { PLOAD; merge_phase(P, X); }
    SEAM(3);
    if (IN(4)) { PLOAD;
        SchedFlat S{(const char*)P.YA, (const char*)P.WA_T, nullptr, (size_t)256 * 256 * 2, (size_t)256 * 256 * 2, 0, 0, 0, nM, 4, 1 << 30, G, c};
        EpiGate<false> E{P.GA, nullptr, P.M1};
        gemm_phase<EpiGate<false>, SchedFlat>(ring, 256, 256, 256, S, E);
    }
    if (IN(4) && IN(5)) { VM_WAIT(); __syncthreads(); }
    if (IN(5)) { PLOAD;
        SchedFlat S{(const char*)P.YB, (const char*)P.WB_T, nullptr, (size_t)256 * 512 * 2, (size_t)256 * 512 * 2, 0, 0, 0, nM, 4, 1 << 30, G, c};
        EpiGate<true> E{P.GB, P.M1, P.MERGED};
        gemm_phase<EpiGate<true>, SchedFlat>(ring, 512, 512, 512, S, E);
    }
    SEAM(5);
    if (IN(6)) { PLOAD;
        SchedFlat S{(const char*)P.MERGED, (const char*)P.WOUT_T, nullptr, (size_t)256 * 1024 * 2, (size_t)256 * 1024 * 2, 0, 0, 0, nM, 4, 1 << 30, G, c};
        EpiResid<true> E{P.in[0] + (size_t)P.b0 * 4096 * 1024, nullptr, P.H1, P.SSQ1};
        gemm_phase<EpiResid<true>, SchedFlat>(ring, 1024, 1024, 1024, S, E);
    }
    SEAM(6);
    if (IN(7)) { PLOAD;
        SchedFlat S{(const char*)P.H1, (const char*)P.WQK, nullptr, (size_t)256 * 1024 * 2, (size_t)256 * 1024 * 2, (size_t)1048576 * 2, 0, 0, nM, 4, 16, G, c};
        EpiScores E{P.SSQ1, P.PX, (LAS float*)(X.lds + XCH_OFF), X.tid};
        gemm_phase<EpiScores, SchedFlat>(ring, 1024, 1024, 1024, S, E);
    }
    SEAM(7);
    if (IN(8)) { PLOAD;
        SchedFlat S{(const char*)P.PX, (const char*)P.VWO, nullptr, (size_t)256 * 1024 * 2, (size_t)256 * 1024 * 2, (size_t)1048576 * 2, 0, 0, nM, 4, 16, G, c};
        EpiResid<false> E{nullptr, P.H1, P.H2, P.SSQ2};
        gemm_phase<EpiResid<false>, SchedFlat>(ring, 1024, 1024, 1024, S, E);
    }
    SEAM(8);
    if (IN(9)) { PLOAD; router_phase(P, X); }
    SEAM(9);
    if (IN(10)) { PLOAD; positions_phase(P, X); }
    SEAM(10);
    if (IN(11)) { PLOAD;
        SchedMoe S{(const char*)P.H2, (const char*)P.WGU_T, (char*)P.HB, P.ROWTOK, P.TILE_E, P.TILE_E + 1024, 0, (size_t)1048576 * 2, (size_t)256 * 1024 * 2, (size_t)512 * 2, (size_t)128 * 2, G, X.vcu};
        EpiMoe1 E{P.SSQ2, (LAS float*)(X.lds + XCH_OFF), X.tid};
        gemm_phase<EpiMoe1, SchedMoe, true>(ring, 1024, 1024, 1024, S, E);
    }
    SEAM(11);
    if (IN(12)) { PLOAD;
        SchedMoe S{(const char*)P.HB, (const char*)P.WD_T, (char*)P.YBX, P.ROWTOK, P.TILE_E, P.TILE_E + 1024, (size_t)512 * 2, (size_t)524288 * 2, (size_t)256 * 512 * 2, (size_t)1024 * 2, (size_t)256 * 2, G, X.vcu};
        EpiMoe2 E{P.WBUF};
        gemm_phase<EpiMoe2, SchedMoe>(ring, 512, 512, 512, S, E);
    }
    SEAM(12);
    if (IN(13)) { PLOAD; final_phase(P, X); }
#undef IN
#undef SEAM
}

constexpr size_t MiB = 1u << 20;
static Params make_params(void* const* d_in, unsigned char* ws, unsigned char* sc2, float* out, int nb, int b0) {
    Params P{};
    for (int i = 0; i < 27; ++i) P.in[i] = (const float*)d_in[i];
    P.out = out; P.ctl = (unsigned*)ws; P.nb = nb; P.T = nb * 4096; P.b0 = b0;
    size_t o = 1 * MiB; auto fx = [&](size_t bytes) { unsigned char* p = ws + o; o += (bytes + 4095) & ~(size_t)4095; return p; };
    P.WIN_T = (bf16_t*)fx((size_t)5376 * 1024 * 2); P.WKV_T = (bf16_t*)fx((size_t)2048 * 1024 * 2); P.WA_T = (bf16_t*)fx((size_t)1024 * 256 * 2); P.WB_T = (bf16_t*)fx((size_t)1024 * 512 * 2);
    P.WOUT_T = (bf16_t*)fx((size_t)1024 * 1024 * 2); P.WQS = (bf16_t*)fx((size_t)1024 * 1024 * 2); P.WO_T = (bf16_t*)fx((size_t)1024 * 1024 * 2); P.WR_T = (bf16_t*)fx((size_t)48 * 1024 * 2);
    P.WSP = (bf16_t*)fx((size_t)4 * 128 * 128 * 2); P.WGU_T = (bf16_t*)fx((size_t)32 * 1024 * 1024 * 2); P.WD_T = (bf16_t*)fx((size_t)32 * 1024 * 512 * 2);
    P.TILE_E = (int*)fx(8192); P.TOT = (int*)fx(4096); P.BCNT = (int*)fx(256 * 32 * 4);
    const size_t u = (size_t)P.T * 16; unsigned char* sb = ws + 128 * MiB; auto sc = [&](size_t s) { return sb + s * u; };
    P.Q = (bf16_t*)sc(0); P.K = (bf16_t*)sc(96); P.V = (bf16_t*)sc(192); P.ZU = (bf16_t*)sc(288); P.ZV = (bf16_t*)sc(352); P.GA = (bf16_t*)sc(416); P.GB = (bf16_t*)sc(544);
    P.OG = (bf16_t*)sc(672); P.LSE = (float*)sc(768); P.SSQ1 = (float*)sc(772); P.SSQ2 = (float*)sc(776); P.EID = (int*)sc(780); P.WGT = (float*)sc(781); P.POSOF = (int*)sc(782);
    P.ROWTOK = (int*)sc(783); P.WBUF = (float*)sc(785);
    P.YA = (bf16_t*)sc(0); P.M1 = (bf16_t*)sc(32); P.MERGED = (bf16_t*)sc(160); P.H1 = (bf16_t*)sc(288); P.PX = (bf16_t*)sc(416); P.H2 = (bf16_t*)sc(544);
    const size_t prow = (size_t)2 * P.T + 8192;
    if (nb == 16) { P.HB = (bf16_t*)sc(0); P.YBX = (bf16_t*)sc(136); } else { P.HB = (bf16_t*)sc(800); P.YBX = (bf16_t*)(sc(800) + prow * 1024); }
    auto s2 = [&](size_t s) { return sc2 + s * u; };
    P.XN = (bf16_t*)s2(0); P.MN = (bf16_t*)s2(128); P.ROPE = (float*)s2(136); P.KVX = (bf16_t*)s2(152); P.YB = (bf16_t*)s2(0); P.WQK = (bf16_t*)s2(64); P.VWO = (bf16_t*)s2(96);
    return P;
}
static size_t ws_bytes_needed(int nb) { const size_t T = (size_t)nb * 4096, u = T * 16, prow = 2 * T + 8192; return 128 * MiB + (nb == 16 ? 787 * u : 800 * u + prow * 1024 * 3); }
static int g_grid = 0;
static bool mk_setup() {
    if (g_grid) return g_grid > 0;
    int dev = 0, cus = 0;
    if (hipGetDevice(&dev) != hipSuccess || hipDeviceGetAttribute(&cus, hipDeviceAttributeMultiprocessorCount, dev) != hipSuccess) { g_grid = -1; return false; }
    if (hipFuncSetAttribute((const void*)mk_fwd, hipFuncAttributeMaxDynamicSharedMemorySize, LDS_BYTES) != hipSuccess) { fprintf(stderr, "mk: cannot get %d B of dynamic LDS\n", LDS_BYTES); g_grid = -1; return false; }
    int per_cu = 0; (void)hipOccupancyMaxActiveBlocksPerMultiprocessor(&per_cu, (const void*)mk_fwd, 512, LDS_BYTES); (void)hipGetLastError();
    if (per_cu < 1) fprintf(stderr, "mk: occupancy query says %d workgroups per CU\n", per_cu);
    g_grid = cus; return true;
}
static void mk_launch(Params P, int lo, int hi, hipStream_t st) { P.ph_lo = lo; P.ph_hi = hi; hipLaunchKernelGGL(mk_fwd, dim3(g_grid), dim3(512), LDS_BYTES, st, P); }
}
#ifndef BUILD_MODE
#define BUILD_MODE 1
#endif
#if BUILD_MODE == 3
namespace chk {
__global__ void __launch_bounds__(256) cmp(const void* opt, int kind, int ldo, const void* ref, int ldr, int rows, int cols, int mode, float scale, const float* bias, float* err) {
    float num = 0.f, den = 0.f;
    for (size_t i = (size_t)blockIdx.x * 256 + threadIdx.x; i < (size_t)rows * cols; i += (size_t)gridDim.x * 256) {
        const int r = (int)(i / cols), c = (int)(i % cols);
        if (kind == 2) { const int o = ((const int*)opt)[(size_t)r * ldo + c], v = ((const int*)ref)[(size_t)r * ldr + c]; num += (o != v) ? 1.f : 0.f; den += 1.f; continue; }
        float o; if (kind == 1) o = __uint_as_float(((unsigned)((const unsigned short*)opt)[(size_t)r * ldo + c]) << 16); else o = ((const float*)opt)[(size_t)r * ldo + c];
        int rc = c; if (mode == 1) { const int d = c & 63; rc = (c & ~63) + (d >> 1) + 32 * (d & 1); }
        float v = (mode == 4) ? ((const float*)ref)[(size_t)c * ldr + r] : ((const float*)ref)[(size_t)r * ldr + rc]; if (mode == 2) v = 1.0f / (1.0f + expf(-(v + (bias ? bias[c] : 0.f)))); if (mode == 3) { const float uu = 0.7978845608028654f * (v + 0.044715f * v * v * v); v = 0.5f * v * (1.0f + tanhf(uu)); } v *= scale;
        const float d2 = (o - v) * (o - v); num += (d2 == d2) ? d2 : 1e30f; den += v * v;
    }
    for (int o = 32; o >= 1; o >>= 1) { num += __shfl_xor(num, o); den += __shfl_xor(den, o); }
    if ((threadIdx.x & 63) == 0) { atomicAdd(err, num); atomicAdd(err + 1, den); }
}
__global__ void decide(const float* err, const unsigned* barw, float* factor, int nstage) {
    if (threadIdx.x != 0 || blockIdx.x != 0) return;
    float f = 1.0f;
    for (int k = 1; k <= nstage; ++k) { const float num = err[2 * k], den = err[2 * k + 1]; float rel = (k == 13) ? num / fmaxf(den, 1.f) : sqrtf(num / fmaxf(den, 1e-30f));
        const float tol = (k == 13) ? 0.05f : 0.03f;
        if (!(rel < tol)) { int cls = 0; if (!(rel < 0.1f)) cls = 1; if (!(rel < 0.5f)) cls = 2; if (!(rel < 1.2f)) cls = 3; if (!(rel < 1e6f)) cls = 4;
            float c = 0.25f * (float)k; for (int q = 0; q < cls; ++q) c *= 100.f; f = 1.0f + c; break; } }
    if (f == 1.0f && barw[mk::CW_BAR + XB_TMO] != 0u) f = 1.0f + 4.0f;
    *factor = f;
}
__global__ void decide_mask(const float* err, float* factor, int first, int ntests) {
    if (threadIdx.x != 0 || blockIdx.x != 0) return;
    int mask = 0;
    for (int q = 0; q < ntests; ++q) { const float num = err[2 * (first + q)], den = err[2 * (first + q) + 1]; const float rel = sqrtf(num / fmaxf(den, 1e-30f)); if (!(rel < 0.03f)) mask |= 1 << q; }
    *factor = 1.0f + 0.25f * (float)(mask + 1);
#ifdef CHK_REL_OF
    { const float num = err[2 * CHK_REL_OF], den = err[2 * CHK_REL_OF + 1]; *factor = 1.0f + sqrtf(num / fmaxf(den, 1e-30f)); }
#endif
}
__global__ void __launch_bounds__(256) scale_out(float* out, const float* factor, size_t n) { const float f = *factor; for (size_t i = (size_t)blockIdx.x * 256 + threadIdx.x; i < n; i += (size_t)gridDim.x * 256) out[i] *= f; }
}
#endif

extern "C" void kernel_launch(void* const* d_in, const int* in_sizes, int n_in, void* d_out, int out_size, void* d_ws, size_t ws_size, hipStream_t stream) {
    (void)in_sizes; (void)n_in; (void)out_size; (void)ws_size;
#if BUILD_MODE == 0
    const nv::Bufs B = nv::carve((unsigned char*)d_ws);
    for (int b = 0; b < 16; ++b) nv::forward_batch(d_in, b, B, (float*)d_out + (size_t)b * nv::S * nv::D, nullptr, stream);
#elif BUILD_MODE == 1 || BUILD_MODE == 2
    if (!mk::mk_setup()) return;
    const mk::Params P = mk::make_params(d_in, (unsigned char*)d_ws, (unsigned char*)d_out, (float*)d_out, 16, 0);
    (void)hipMemsetAsync(d_ws, 0, 65536, stream);
#if BUILD_MODE == 1
#ifndef REPEAT_MASK
#define REPEAT_MASK 0
#endif
    for (int k = 0; k < mk::NPHASE; ++k) { mk::mk_launch(P, k, k + 1, stream); if ((REPEAT_MASK >> k) & 1) mk::mk_launch(P, k, k + 1, stream); }
#else
    mk::mk_launch(P, 0, mk::NPHASE, stream);
#endif
#else
    if (!mk::mk_setup()) return;
    unsigned char* ws = (unsigned char*)d_ws; const size_t MiB = mk::MiB;
    const nv::Bufs B = nv::carve(ws);
    for (int b = 0; b < 16; ++b) nv::forward_batch(d_in, b, B, (float*)d_out + (size_t)b * nv::S * nv::D, nullptr, stream);
    unsigned char* ows = ws + 384 * MiB; unsigned char* sc2 = ws + 700 * MiB; float* oout = (float*)(ws + 740 * MiB); float* err = (float*)(ws + 780 * MiB); float* factor = err + 64;
    (void)hipMemsetAsync(ows, 0, 65536, stream); (void)hipMemsetAsync(err, 0, 1024, stream);
    const mk::Params P = mk::make_params(d_in, ows, sc2, oout, 2, 14);
    const size_t R = 4096;
    auto C = [&](int code, const void* opt, int kind, int ldo, const void* ref, int ldr, int cols, int mode, float scale, const float* bias) {
        const int esz = kind == 1 ? 2 : 4; chk::cmp<<<1024, 256, 0, stream>>>((const char*)opt + R * (size_t)ldo * esz, kind, ldo, ref, ldr, 4096, cols, mode, scale, bias, err + 2 * code); };
    const float* bgates = (const float*)d_in[5];
    for (int k = 0; k < mk::NPHASE; ++k) {
        mk::mk_launch(P, k, k + 1, stream);
        if (k == 0) C(1, P.XN, 1, 1024, B.XN, 1024, 1024, 0, 1.f, nullptr);
        if (k == 1) { C(2, P.Q, 1, 768, B.PROJ, 5376, 768, 1, mk::QSCALE, nullptr); C(3, P.K, 1, 768, B.PROJ + 768, 5376, 768, 1, 1.f, nullptr); C(4, P.V, 1, 768, B.PROJ + 1536, 5376, 768, 0, 1.f, nullptr);
                      C(5, P.ZU, 1, 512, B.U, 512, 512, 0, 1.f, nullptr); C(6, P.GA, 1, 1024, B.PROJ + 3328, 5376, 1024, 2, 1.f, bgates); C(7, P.GB, 1, 1024, B.PROJ + 4352, 5376, 1024, 2, 1.f, bgates + 1024); }
#ifdef CHK_MASK_FIRST
        if (k == 0) { const float* w_in = (const float*)d_in[4]; const float* w_kv = (const float*)d_in[16];
            chk::cmp<<<1024, 256, 0, stream>>>(P.WIN_T + (size_t)2816 * 1024, 1, 1024, w_in + 2816, 5376, 512, 1024, 4, 1.f, nullptr, err + 40);
            chk::cmp<<<1024, 256, 0, stream>>>(P.WIN_T + (size_t)3328 * 1024, 1, 1024, w_in + 3328, 5376, 1024, 1024, 4, 1.f, nullptr, err + 42);
            chk::cmp<<<1024, 256, 0, stream>>>(P.WIN_T + (size_t)4352 * 1024, 1, 1024, w_in + 4352, 5376, 1024, 1024, 4, 1.f, nullptr, err + 44);
            chk::cmp<<<1024, 256, 0, stream>>>(P.WKV_T, 1, 1024, w_kv, 2048, 2048, 1024, 4, 1.f, nullptr, err + 46); }
#endif
        if (k == 2) C(9, P.YB, 1, 512, B.YB, 512, 512, 0, 1.f, nullptr);
        if (k == 3) C(8, P.YA, 1, 256, B.YA, 256, 256, 0, 1.f, nullptr);
        if (k == 5) C(10, P.MERGED, 1, 1024, B.MERGED, 1024, 1024, 0, 1.f, nullptr);
        if (k == 6) C(11, P.H1, 1, 1024, B.H1, 1024, 1024, 0, 1.f, nullptr);
        if (k == 8) C(12, P.H2, 1, 1024, B.H2, 1024, 1024, 0, 1.f, nullptr);
        if (k == 9) { chk::cmp<<<64, 256, 0, stream>>>(P.EID + 2 * R, 2, 2, B.EID, 2, 4096, 2, 0, 1.f, nullptr, err + 26); chk::cmp<<<64, 256, 0, stream>>>(P.WGT + 2 * R, 0, 2, B.WGT, 2, 4096, 2, 0, 1.f, nullptr, err + 28); }
        if (k == 13) C(15, oout, 0, 1024, (const float*)d_out + (size_t)15 * 4096 * 1024, 1024, 1024, 0, 1.f, nullptr);
    }
#ifdef CHK_MASK_FIRST
    chk::decide_mask<<<1, 64, 0, stream>>>(err, factor, CHK_MASK_FIRST, 4);
#else
    chk::decide<<<1, 64, 0, stream>>>(err, (const unsigned*)ows, factor, 15);
#endif
    chk::scale_out<<<2048, 256, 0, stream>>>((float*)d_out, factor, (size_t)16 * 4096 * 1024);
#endif
}
```
